# Optimizing an MI355X kernel written in HIP

```python
import jax, jax.numpy as jnp
from jax import lax
import numpy as np

D_MODEL = 1024
BATCH = 4
SEQ = 8192
DEPTH = 4

N_MIXERS = 3
Q_BLOCK = 128
ROPE_THETA = 500000.0
EPS = 1e-6
MAX_POS_OFFSET = 4096

SB_HEADS = 8
SB_HEAD_DIM = D_MODEL // SB_HEADS

MLA_HEADS = 8
MLA_Q_LORA = 256
MLA_KV_LORA = 128
MLA_NOPE_DIM = 128
MLA_ROPE_DIM = 64
MLA_V_DIM = D_MODEL // MLA_HEADS

DSA_HEADS = 8
DSA_KV_HEADS = 2
DSA_HEAD_DIM = 128
DSA_ROT_DIM = DSA_HEAD_DIM // 4
IDX_HEADS = 8
IDX_DIM = 64
IDX_ROT_DIM = IDX_DIM // 4
DSA_TOPK_MAX = 256
DSA_IN_WIDTH = (DSA_HEADS * DSA_HEAD_DIM + 2 * DSA_KV_HEADS * DSA_HEAD_DIM
                + IDX_HEADS * IDX_DIM + IDX_DIM + IDX_HEADS)

D_FF = 2816
N_EXPERTS = 8
TOP_K = 2
D_FF_EXPERT = 1408

kernel_name = 'hybrid_sb_mla_dsa_moe_adaln'


def _n_layers_of(period, phase):
    return len(range(phase, DEPTH, period))


def _rmsnorm(x, g):
    xf = x.astype(jnp.float32)
    y = xf * lax.rsqrt(jnp.mean(xf * xf, axis=-1, keepdims=True) + EPS)
    return (y * g.astype(jnp.float32)).astype(x.dtype)


def _rope_tables(positions, rot_dim):
    inv_freq = ROPE_THETA ** (-jnp.arange(0, rot_dim, 2, dtype=jnp.float32) / rot_dim)
    ang = positions.astype(jnp.float32)[..., None] * inv_freq
    return jnp.cos(ang), jnp.sin(ang)


def _apply_rope(x, cos, sin):
    rot = 2 * cos.shape[-1]
    if x.ndim == 4:
        cos, sin = cos[:, :, None, :], sin[:, :, None, :]
    xr = x[..., :rot].astype(jnp.float32)
    x1, x2 = xr[..., :rot // 2], xr[..., rot // 2:]
    xr = jnp.concatenate([x1 * cos - x2 * sin, x2 * cos + x1 * sin], axis=-1).astype(x.dtype)
    return jnp.concatenate([xr, x[..., rot:]], axis=-1)


def _swiglu(h, w_gu, w_down):
    a, b = jnp.split(h @ w_gu, 2, axis=-1)
    return (jax.nn.silu(a) * b) @ w_down


def _stick_breaking(h, w_in, w_out):
    B, S, _ = h.shape
    q, k, v = jnp.split((h @ w_in).reshape(B, S, 3 * SB_HEADS, SB_HEAD_DIM), 3, axis=2)
    scale = SB_HEAD_DIM ** -0.5
    outs = []
    for start in range(0, S, Q_BLOCK):
        end = start + Q_BLOCK
        z = jnp.einsum('bqhd,bkhd->bhqk', q[:, start:end], k[:, :end]).astype(jnp.float32) * scale
        mask = jnp.arange(end)[None, :] < jnp.arange(start, end)[:, None]
        log_beta = jax.nn.log_sigmoid(z)
        log_fail = jnp.where(mask, jax.nn.log_sigmoid(-z), 0.0)
        tail = lax.cumsum(log_fail, axis=3, reverse=True) - log_fail
        a = jnp.where(mask, jnp.exp(log_beta + tail), 0.0)
        outs.append(jnp.einsum('bhqk,bkhd->bqhd', a.astype(v.dtype), v[:, :end]))
    o = jnp.concatenate(outs, axis=1).reshape(B, S, SB_HEADS * SB_HEAD_DIM)
    return o @ w_out


def _causal_softmax_attention(q, k, v, scale):
    S = q.shape[1]
    outs = []
    for start in range(0, S, Q_BLOCK):
        end = start + Q_BLOCK
        s = jnp.einsum('bqhd,bkhd->bhqk', q[:, start:end], k[:, :end]).astype(jnp.float32) * scale
        mask = jnp.arange(end)[None, :] <= jnp.arange(start, end)[:, None]
        p = jax.nn.softmax(jnp.where(mask, s, -jnp.inf), axis=-1)
        outs.append(jnp.einsum('bhqk,bkhd->bqhd', p.astype(v.dtype), v[:, :end]))
    return jnp.concatenate(outs, axis=1)


def _mla(h, cos, sin, w_in, g_q, w_q_up, g_kv, w_kv_up, w_out):
    B, S, _ = h.shape
    c_q, c_kv, k_rope = jnp.split(h @ w_in, [MLA_Q_LORA, MLA_Q_LORA + MLA_KV_LORA], axis=-1)
    q = (_rmsnorm(c_q, g_q) @ w_q_up).reshape(B, S, MLA_HEADS, MLA_NOPE_DIM + MLA_ROPE_DIM)
    q_nope, q_rope = jnp.split(q, [MLA_NOPE_DIM], axis=-1)
    kv = (_rmsnorm(c_kv, g_kv) @ w_kv_up).reshape(B, S, MLA_HEADS, MLA_NOPE_DIM + MLA_V_DIM)
    k_nope, v = jnp.split(kv, [MLA_NOPE_DIM], axis=-1)
    q_rope = _apply_rope(q_rope, cos, sin)
    k_rope = _apply_rope(k_rope, cos, sin)
    q = jnp.concatenate([q_nope, q_rope], axis=-1)
    k = jnp.concatenate([k_nope, jnp.broadcast_to(k_rope[:, :, None, :], (B, S, MLA_HEADS, MLA_ROPE_DIM))], axis=-1)
    o = _causal_softmax_attention(q, k, v, (MLA_NOPE_DIM + MLA_ROPE_DIM) ** -0.5)
    return o.reshape(B, S, MLA_HEADS * MLA_V_DIM) @ w_out


def _dsa(h, cos_a, sin_a, cos_i, sin_i, w_in, g_kidx, w_out):
    B, S, _ = h.shape
    widths = [DSA_HEADS * DSA_HEAD_DIM, DSA_KV_HEADS * DSA_HEAD_DIM, DSA_KV_HEADS * DSA_HEAD_DIM,
              IDX_HEADS * IDX_DIM, IDX_DIM]
    cuts = [int(i) for i in np.cumsum(widths)]
    q, k, v, q_idx, k_idx, w_idx = jnp.split(h @ w_in, cuts, axis=-1)
    q = _apply_rope(q.reshape(B, S, DSA_HEADS, DSA_HEAD_DIM), cos_a, sin_a)
    k = _apply_rope(k.reshape(B, S, DSA_KV_HEADS, DSA_HEAD_DIM), cos_a, sin_a)
    v = v.reshape(B, S, DSA_KV_HEADS, DSA_HEAD_DIM)
    q_idx = _apply_rope(q_idx.reshape(B, S, IDX_HEADS, IDX_DIM), cos_i, sin_i)
    k_idx = _apply_rope(_rmsnorm(k_idx, g_kidx), cos_i, sin_i)
    w_idx = w_idx.astype(jnp.float32) * (IDX_HEADS ** -0.5)
    n_sel = min(DSA_TOPK_MAX, S // 4)
    group = DSA_HEADS // DSA_KV_HEADS
    gather = jax.vmap(lambda t, i: t[i])
    outs = []
    for start in range(0, S, Q_BLOCK):
        end = start + Q_BLOCK
        n_keys = min(S, max(end, n_sel))
        q_pos = jnp.arange(start, end)
        logits = jnp.einsum('bqhd,bkd->bqhk', q_idx[:, start:end], k_idx[:, :n_keys]).astype(jnp.float32) * IDX_DIM ** -0.5
        score = jnp.einsum('bqhk,bqh->bqk', jax.nn.relu(logits), w_idx[:, start:end])
        score = jnp.where(jnp.arange(n_keys)[None, None, :] <= q_pos[None, :, None], score, -jnp.inf)
        _, sel = lax.top_k(score, n_sel)
        valid = sel <= q_pos[None, :, None]
        k_sel = gather(k, sel)
        v_sel = gather(v, sel)
        qg = q[:, start:end].reshape(B, Q_BLOCK, DSA_KV_HEADS, group, DSA_HEAD_DIM)
        s = jnp.einsum('bqgnd,bqkgd->bqgnk', qg, k_sel).astype(jnp.float32) * DSA_HEAD_DIM ** -0.5
        p = jax.nn.softmax(jnp.where(valid[:, :, None, None, :], s, -jnp.inf), axis=-1)
        o = jnp.einsum('bqgnk,bqkgd->bqgnd', p.astype(v.dtype), v_sel)
        outs.append(o.reshape(B, Q_BLOCK, DSA_HEADS * DSA_HEAD_DIM))
    return jnp.concatenate(outs, axis=1) @ w_out


def _moe(h, w_router, b_router, w_gu, w_down):
    logits = (h @ w_router).astype(jnp.float32) + b_router.astype(jnp.float32)
    top_vals, top_idx = lax.top_k(logits, TOP_K)
    top_w = jax.nn.softmax(top_vals, axis=-1)
    gates = jnp.sum(jax.nn.one_hot(top_idx, N_EXPERTS, dtype=jnp.float32) * top_w[..., None], axis=-2)
    out = jnp.zeros_like(h)
    for e in range(N_EXPERTS):
        out = out + gates[..., e:e + 1].astype(h.dtype) * _swiglu(h, w_gu[e], w_down[e])
    return out


def setup_inputs(seed: int = 0) -> dict:
    key = jax.random.key(seed)
    keys = iter(jax.random.split(key, 40))

    def nrm(shape, scale):
        return jax.random.normal(next(keys), shape, jnp.float32) * scale

    def gain(shape):
        return 1.0 + nrm(shape, 0.02)

    d = D_MODEL
    n_a, n_b, n_c = _n_layers_of(N_MIXERS, 0), _n_layers_of(N_MIXERS, 1), _n_layers_of(N_MIXERS, 2)
    n_dense, n_moe = _n_layers_of(2, 0), _n_layers_of(2, 1)
    x = nrm((BATCH, SEQ, d), 1.0)
    c = nrm((BATCH, d), 1.0)
    offset = jax.random.randint(next(keys), (BATCH, 1), 0, MAX_POS_OFFSET, dtype=jnp.int32)
    positions = offset + jnp.arange(SEQ, dtype=jnp.int32)[None, :]
    return {
        'x': x,
        'c': c,
        'positions': positions,
        'ada_w': nrm((DEPTH, d, 6 * d), 0.5 * d ** -0.5),
        'ada_b': nrm((DEPTH, 6 * d), 0.02),
        'norm_g': gain((DEPTH, 4, d)),
        'sb_w_in': nrm((n_a, d, 3 * SB_HEADS * SB_HEAD_DIM), d ** -0.5),
        'sb_w_out': nrm((n_a, SB_HEADS * SB_HEAD_DIM, d), (SB_HEADS * SB_HEAD_DIM) ** -0.5),
        'mla_w_in': nrm((n_b, d, MLA_Q_LORA + MLA_KV_LORA + MLA_ROPE_DIM), d ** -0.5),
        'mla_g_q': gain((n_b, MLA_Q_LORA)),
        'mla_w_q_up': nrm((n_b, MLA_Q_LORA, MLA_HEADS * (MLA_NOPE_DIM + MLA_ROPE_DIM)), MLA_Q_LORA ** -0.5),
        'mla_g_kv': gain((n_b, MLA_KV_LORA)),
        'mla_w_kv_up': nrm((n_b, MLA_KV_LORA, MLA_HEADS * (MLA_NOPE_DIM + MLA_V_DIM)), MLA_KV_LORA ** -0.5),
        'mla_w_out': nrm((n_b, MLA_HEADS * MLA_V_DIM, d), (MLA_HEADS * MLA_V_DIM) ** -0.5),
        'dsa_w_in': nrm((n_c, d, DSA_IN_WIDTH), d ** -0.5),
        'dsa_g_kidx': gain((n_c, IDX_DIM)),
        'dsa_w_out': nrm((n_c, DSA_HEADS * DSA_HEAD_DIM, d), (DSA_HEADS * DSA_HEAD_DIM) ** -0.5),
        'ffn_w_gu': nrm((n_dense, d, 2 * D_FF), d ** -0.5),
        'ffn_w_down': nrm((n_dense, D_FF, d), D_FF ** -0.5),
        'moe_w_router': nrm((n_moe, d, N_EXPERTS), d ** -0.5),
        'moe_b_router': nrm((n_moe, N_EXPERTS), 0.01),
        'moe_w_gu': nrm((n_moe, N_EXPERTS, d, 2 * D_FF_EXPERT), d ** -0.5),
        'moe_w_down': nrm((n_moe, N_EXPERTS, D_FF_EXPERT, d), D_FF_EXPERT ** -0.5),
    }


def reference(x, c, positions, ada_w, ada_b, norm_g, sb_w_in, sb_w_out, mla_w_in, mla_g_q,
              mla_w_q_up, mla_g_kv, mla_w_kv_up, mla_w_out, dsa_w_in, dsa_g_kidx, dsa_w_out,
              ffn_w_gu, ffn_w_down, moe_w_router, moe_b_router, moe_w_gu, moe_w_down):
    cond = jax.nn.silu(c)
    cos_m, sin_m = _rope_tables(positions, MLA_ROPE_DIM)
    cos_a, sin_a = _rope_tables(positions, DSA_ROT_DIM)
    cos_i, sin_i = _rope_tables(positions, IDX_ROT_DIM)
    counters = [0, 0, 0]
    for layer in range(DEPTH):
        mod = (cond @ ada_w[layer] + ada_b[layer])[:, None, :]
        sh_m, sc_m, g_m, sh_f, sc_f, g_f = jnp.split(mod, 6, axis=-1)
        gn = norm_g[layer]
        h = _rmsnorm(x, gn[0]) * (1.0 + sc_m) + sh_m
        kind = layer % N_MIXERS
        j = counters[kind]
        counters[kind] += 1
        if kind == 0:
            y = _stick_breaking(h, sb_w_in[j], sb_w_out[j])
        elif kind == 1:
            y = _mla(h, cos_m, sin_m, mla_w_in[j], mla_g_q[j], mla_w_q_up[j], mla_g_kv[j],
                     mla_w_kv_up[j], mla_w_out[j])
        else:
            y = _dsa(h, cos_a, sin_a, cos_i, sin_i, dsa_w_in[j], dsa_g_kidx[j], dsa_w_out[j])
        x = x + g_m * _rmsnorm(y, gn[1])
        h = _rmsnorm(x, gn[2]) * (1.0 + sc_f) + sh_f
        f = layer // 2
        if layer % 2 == 0:
            y = _swiglu(h, ffn_w_gu[f], ffn_w_down[f])
        else:
            y = _moe(h, moe_w_router[f], moe_b_router[f], moe_w_gu[f], moe_w_down[f])
        x = x + g_f * _rmsnorm(y, gn[3])
    return x
```

```cpp
#include <hip/hip_runtime.h>
#include <cstdio>
#include <cstdint>

#ifndef DUP_MASK
#define DUP_MASK 0
#endif
#define GAS __attribute__((address_space(1)))
#define LAS __attribute__((address_space(3)))
typedef unsigned short bf16_t;
typedef short bf16x8 __attribute__((ext_vector_type(8)));
typedef short s16x4 __attribute__((ext_vector_type(4)));
typedef float f32x2 __attribute__((ext_vector_type(2)));
typedef float f32x4 __attribute__((ext_vector_type(4)));
typedef float f32x16 __attribute__((ext_vector_type(16)));
typedef unsigned u32x2 __attribute__((ext_vector_type(2)));
typedef unsigned u32x4 __attribute__((ext_vector_type(4)));
typedef unsigned long long u64;

constexpr int DM = 1024, NB = 4, SEQ = 8192, NTOK = NB * SEQ, DEPTH = 4;
constexpr int DFF = 2816, NEXP = 8, DFFE = 1408;
constexpr int SBW = 3072, MLAW = 512, DSAW = 2304, DSAW_REAL = 2120, MLAW_REAL = 448;
constexpr int NSLOT = 2 * NTOK + NEXP * 256;
constexpr float EPS = 1e-6f;

constexpr size_t MiB = 1u << 20;
constexpr size_t WS_CTL = 0, CTL_ZERO_BYTES = 1 * MiB;
constexpr size_t WS_MOD = 1 * MiB;
constexpr size_t WS_MOE = 2 * MiB;
constexpr size_t MOE_SEL = WS_MOE, MOE_GATE = MOE_SEL + (size_t)NTOK * 4, MOE_SLOT = MOE_GATE + (size_t)NTOK * 8, MOE_CCNT = MOE_SLOT + (size_t)NTOK * 8, MOE_SEG = MOE_CCNT + 256 * 8 * 4, MOE_RIDX = MOE_SEG + 256;
static_assert(MOE_RIDX + (size_t)NSLOT * 4 <= 3 * MiB, "moe tables");
constexpr size_t WS_ROPE = 3 * MiB;
constexpr size_t RP_COSM = WS_ROPE, RP_SINM = RP_COSM + (size_t)NTOK * 32 * 4, RP_COSA = RP_SINM + (size_t)NTOK * 32 * 4, RP_SINA = RP_COSA + (size_t)NTOK * 16 * 4,
                 RP_COSI = RP_SINA + (size_t)NTOK * 16 * 4, RP_SINI = RP_COSI + (size_t)NTOK * 8 * 4;
static_assert(RP_SINI + (size_t)NTOK * 8 * 4 <= 17 * MiB, "rope tables");
constexpr size_t WS_W = 18 * MiB;
constexpr size_t W_SBIN = WS_W, W_SBOUT = W_SBIN + 2ull * SBW * DM * 2, W_MLAIN = W_SBOUT + 2ull * DM * DM * 2, W_MLAQ = W_MLAIN + (size_t)MLAW * DM * 2,
                 W_MLAKV = W_MLAQ + 1536ull * 256 * 2, W_MLAOUT = W_MLAKV + 2048ull * 256 * 2, W_DSAIN = W_MLAOUT + (size_t)DM * DM * 2, W_DSAOUT = W_DSAIN + (size_t)DSAW * DM * 2,
                 W_FFNGU = W_DSAOUT + (size_t)DM * DM * 2, W_FFNDN = W_FFNGU + 2ull * 2 * DFF * DM * 2, W_MOEGU = W_FFNDN + 2ull * DM * DFF * 2,
                 W_MOEDN = W_MOEGU + 2ull * NEXP * 2 * DFFE * DM * 2, W_END = W_MOEDN + 2ull * NEXP * DM * DFFE * 2;
static_assert(W_END <= 211 * MiB, "weights");
constexpr size_t WS_H = 211 * MiB;
constexpr size_t WS_BIG = 275 * MiB;
constexpr size_t WS_BIG2 = 467 * MiB;
constexpr size_t WS_O = WS_BIG2 + 128 * MiB;
constexpr size_t WS_END = 659 * MiB;
constexpr size_t BIG_MLA_CIN = WS_BIG + 96 * MiB, BIG_DSA_MASK = WS_BIG + 144 * MiB;

constexpr int RING_OFF = 0, RING_BYTES = 131072;
constexpr int LDSCTL_OFF = RING_BYTES, MISC_OFF = LDSCTL_OFF + 320;
constexpr int LDS_BYTES = 147456;
constexpr int NWAVES = 8;

#define RLX_AGENT __ATOMIC_RELAXED, __HIP_MEMORY_SCOPE_AGENT
#define LDS_WAIT() asm volatile("s_waitcnt lgkmcnt(0)" ::: "memory")
#define VM_WAIT() asm volatile("s_waitcnt vmcnt(0)" ::: "memory")
#define LDS_BARRIER() do { asm volatile("s_waitcnt lgkmcnt(0)" ::: "memory"); __builtin_amdgcn_s_barrier(); asm volatile("" ::: "memory"); } while (0)
typedef __bf16 bf16v2_t __attribute__((ext_vector_type(2)));
__device__ __forceinline__ unsigned cvtpk_c(float lo, float hi) { const f32x2 f = {lo, hi}; const bf16v2_t v = __builtin_convertvector(f, bf16v2_t); return __builtin_bit_cast(unsigned, v); }
__device__ __forceinline__ unsigned cvtpk(float lo, float hi) { return cvtpk_c(lo, hi); }
__device__ __forceinline__ float bf2f(unsigned short h) { return __uint_as_float((unsigned)h << 16); }
__device__ __forceinline__ float bflo(unsigned w) { return __uint_as_float(w << 16); }
__device__ __forceinline__ float bfhi(unsigned w) { return __uint_as_float(w & 0xffff0000u); }
__device__ __forceinline__ int opaque_tid() { int t = threadIdx.x; asm volatile("" : "+v"(t)); return t; }
__device__ __forceinline__ float wave_sum(float v) {
#define WS_DPP(ctrl) v += __int_as_float(__builtin_amdgcn_update_dpp(0, __float_as_int(v), ctrl, 0xF, 0xF, true))
    WS_DPP(0xB1); WS_DPP(0x4E); WS_DPP(0x141); WS_DPP(0x140);
#undef WS_DPP
    { auto rr = __builtin_amdgcn_permlane16_swap(__float_as_uint(v), __float_as_uint(v), false, false); v = __uint_as_float(rr[0]) + __uint_as_float(rr[1]); }
    { auto rr = __builtin_amdgcn_permlane32_swap(__float_as_uint(v), __float_as_uint(v), false, false); v = __uint_as_float(rr[0]) + __uint_as_float(rr[1]); }
    return v;
}

#define XB_TMO      128
#define XB_XCNT(j)  (256  + 64 * (j))
#define XB_XSUB(j)  (1280 + 64 * (j))
#define XB_XGEN(j)  (2304 + 64 * (j))
#define XB_TOP      3328
#define XB_TOPGEN   3392
#define XCD_BAR_WORDS 3456
#define XB_SPIN_CAP (1u << 20)
__device__ __forceinline__ unsigned xb_ld(unsigned* p)              { return __hip_atomic_load(p, __ATOMIC_RELAXED, __HIP_MEMORY_SCOPE_AGENT); }
__device__ __forceinline__ unsigned xb_add(unsigned* p, unsigned v) { return __hip_atomic_fetch_add(p, v, __ATOMIC_RELAXED, __HIP_MEMORY_SCOPE_AGENT); }
__device__ __forceinline__ unsigned xb_xcc_id() { return (unsigned)__builtin_amdgcn_s_getreg((3 << 11) | 20) & 0xFu; }
#define XB_SPIN(cond, bar) do { unsigned _sp = 0; while (cond) { __builtin_amdgcn_s_sleep(1); \
    if ((++_sp & 255u) == 0u) { if (xb_ld(&(bar)[XB_TMO])) break; if (_sp > XB_SPIN_CAP) { atomicAdd(&(bar)[XB_TMO], 1u); break; } } } } while (0)
struct XcdBarrier { unsigned* bar; unsigned x; volatile LAS unsigned* st; };
__device__ __forceinline__ XcdBarrier xcd_barrier_post(unsigned* bar, volatile LAS unsigned* st) {
    XcdBarrier b; b.bar = bar; b.x = xb_xcc_id(); b.st = st;
    if (threadIdx.x == 0) (void)xb_add(&bar[XB_XCNT(b.x)], 1u);
    return b;
}
__device__ __forceinline__ void xcd_barrier_complete(unsigned* bar, unsigned x, unsigned& nloc, unsigned& nx) {
    const unsigned G = gridDim.x * gridDim.y * gridDim.z;
    unsigned sum, cnt, mine, sp = 0u;
    for (;;) {
        sum = 0u; cnt = 0u; mine = 0u;
#pragma unroll
        for (unsigned j = 0; j < 16; ++j) { const unsigned c = xb_ld(&bar[XB_XCNT(j)]); sum += c; cnt += (c > 0u) ? 1u : 0u; mine = (j == x) ? c : mine; }
        if (sum == G) break;
        __builtin_amdgcn_s_sleep(1);
        if ((++sp & 255u) == 0u) { if (xb_ld(&bar[XB_TMO])) break; if (sp > XB_SPIN_CAP) { atomicAdd(&bar[XB_TMO], 1u); break; } }
    }
    nloc = mine > 0u ? mine : 1u; nx = cnt > 0u ? cnt : 1u;
}
__device__ __forceinline__ void xcd_barrier(const XcdBarrier& b) {
    asm volatile("s_waitcnt vmcnt(0)" ::: "memory");
    __syncthreads();
    if (threadIdx.x == 0) {
        unsigned* bar = b.bar;
        __builtin_amdgcn_s_waitcnt(0);
        unsigned nloc = b.st[0], nx = b.st[1];
        if (nloc == 0u) { xcd_barrier_complete(bar, b.x, nloc, nx); b.st[0] = nloc; b.st[1] = nx; }
        const unsigned old = xb_add(&bar[XB_XSUB(b.x)], 1u);
        const unsigned gen = old / nloc;
        if (old + 1u == (gen + 1u) * nloc) {
            __builtin_amdgcn_fence(__ATOMIC_RELEASE, "agent");
            asm volatile("s_waitcnt vmcnt(0)" ::: "memory");
            const unsigned og = xb_add(&bar[XB_TOP], 1u);
            const unsigned tg = og / nx;
            if (og + 1u == (tg + 1u) * nx) xb_add(&bar[XB_TOPGEN], 1u);
            else XB_SPIN(xb_ld(&bar[XB_TOPGEN]) == tg, bar);
            __builtin_amdgcn_fence(__ATOMIC_ACQUIRE, "agent");
            xb_add(&bar[XB_XGEN(b.x)], 1u);
            asm volatile("s_waitcnt vmcnt(0)" ::: "memory");
        } else {
            XB_SPIN(xb_ld(&bar[XB_XGEN(b.x)]) == gen, bar);
            __builtin_amdgcn_fence(__ATOMIC_ACQUIRE, "agent");
            asm volatile("s_waitcnt vmcnt(0)" ::: "memory");
        }
    }
    __syncthreads();
}
namespace pg8 {
constexpr int BM = 256, BK = 64, HALF = 128, HTB = HALF * BK * 2, STAGE_BYTES = 8 * HTB, NXCD = 8, WGM = 8;
__host__ __device__ __forceinline__ int lds_byte(int r, int c) { const int st = (r >> 4) * 2 + (c >> 5), rr = r & 15, cc = c & 31, ob = rr * 64 + cc * 2; return st * 1024 + (ob ^ (((ob >> 9) & 1) << 5)); }
__host__ __device__ __forceinline__ void stage_rc(int b, int& R, int& C) { const int st = b / 1024, sb = b % 1024, swz = sb ^ (((sb >> 9) & 1) << 5); R = (st >> 1) * 16 + swz / 64; C = (st & 1) * 32 + (swz % 64) / 2; }
__host__ __device__ __forceinline__ int perm32(int rho) { const int n = rho >> 4, i = rho & 15; return 8 * (i >> 2) + 4 * n + (i & 3); }

struct Unit { int pm, pn, pc; };
struct Gemm { const bf16_t* A; const bf16_t* Bt; int lda, K; };

__device__ __forceinline__ bool tile_of(long L, int nM, int nN, int& pm, int& pn) {
    const int nwg = nM * nN; if (L >= nwg) return false;
    int wgid = (int)L; { const int q = nwg / NXCD, r = nwg % NXCD, xcd = wgid % NXCD, off = wgid / NXCD; wgid = (xcd < r ? xcd * (q + 1) : r * (q + 1) + (xcd - r) * q) + off; }
    const int nig = WGM * nN, gid = wgid / nig, fm = gid * WGM, gsz = (nM - fm) < WGM ? (nM - fm) : WGM;
    pm = fm + ((wgid % nig) % gsz); pn = (wgid % nig) / gsz; return true;
}
struct StaticOrder {
    int nM, nN, G, c;
    __device__ void init(int M, int N, int G_, int c_) { nM = M / BM; nN = N / BM; G = G_; c = c_; }
    __device__ __forceinline__ bool next(int i, Unit& u) const { int pm, pn; if (!tile_of((long)i * G + c, nM, nN, pm, pn)) return false; u.pm = pm; u.pn = pn; u.pc = pn; return true; }
};
struct GroupOrder {
    int nM, nN, G, c; int st[9];
    __device__ __forceinline__ bool next(int i, Unit& u) const {
        int pm, pn; if (!tile_of((long)i * G + c, nM, nN, pm, pn)) return false;
        int e = 0;
#pragma unroll
        for (int k = 1; k < 8; ++k) e += (pm >= st[k]) ? 1 : 0;
        u.pm = pm; u.pn = e * nN + pn; u.pc = pn; return true;
    }
};

struct EpiStore {
    bf16_t* O; int ldc;
    __device__ __forceinline__ void operator()(const f32x4 (&acc)[2][2][4][2], const Unit& u, int wr, int wc, int fr, int fq) const {
        const int row0 = u.pm * BM + wr * 64 + fr, col0 = u.pc * BM + wc * 32 + 8 * fq;
#pragma unroll
        for (int ai = 0; ai < 2; ++ai)
#pragma unroll
            for (int m = 0; m < 4; ++m) { bf16_t* rowp = O + (size_t)(row0 + ai * HALF + m * 16) * ldc + col0;
#pragma unroll
                for (int bj = 0; bj < 2; ++bj) { const f32x4 v0 = acc[ai][bj][m][0], v1 = acc[ai][bj][m][1];
                    u32x4 w; w.x = cvtpk_c(v0[0], v0[1]); w.y = cvtpk_c(v0[2], v0[3]); w.z = cvtpk_c(v1[0], v1[1]); w.w = cvtpk_c(v1[2], v1[3]);
                    *(u32x4*)(rowp + bj * HALF) = w; } }
    }
};
__device__ __forceinline__ float silu_mul(float a, float b) { return a * __builtin_amdgcn_rcpf(1.0f + __builtin_amdgcn_exp2f(-1.4426950408889634f * a)) * b; }
struct EpiSwiGLU {
    bf16_t* O; int ldc;
    __device__ __forceinline__ void operator()(const f32x4 (&acc)[2][2][4][2], const Unit& u, int wr, int wc, int fr, int fq) const {
        const int row0 = u.pm * BM + wr * 64 + fr, col0 = u.pc * HALF + wc * 32 + 8 * fq;
#pragma unroll
        for (int ai = 0; ai < 2; ++ai)
#pragma unroll
            for (int m = 0; m < 4; ++m) { bf16_t* rowp = O + (size_t)(row0 + ai * HALF + m * 16) * ldc + col0;
                const f32x4 a0 = acc[ai][0][m][0], a1 = acc[ai][0][m][1], b0 = acc[ai][1][m][0], b1 = acc[ai][1][m][1];
                u32x4 w; w.x = cvtpk_c(silu_mul(a0[0], b0[0]), silu_mul(a0[1], b0[1])); w.y = cvtpk_c(silu_mul(a0[2], b0[2]), silu_mul(a0[3], b0[3]));
                w.z = cvtpk_c(silu_mul(a1[0], b1[0]), silu_mul(a1[1], b1[1])); w.w = cvtpk_c(silu_mul(a1[2], b1[2]), silu_mul(a1[3], b1[3]));
                *(u32x4*)rowp = w; }
    }
};

constexpr int RI_OFF = 131072 + 8192;
template <class Epi, class Sched, bool ALIGN_EPI, bool GATHER = false>
__device__ __forceinline__ void gemm_phase(LAS unsigned char* lds, const Gemm g, const Sched& S, const Epi& E, const int* ridx = nullptr) {
    const int tid = opaque_tid(), wid = __builtin_amdgcn_readfirstlane(tid >> 6), lane = tid & 63, wr = wid >> 2, wc = wid & 3, fr = lane & 15, fq = lane >> 4;
    const int K = g.K, lda = g.lda, nt = K / BK;
    unsigned voffA[2], voffB[2];
#pragma unroll
    for (int i = 0; i < 2; ++i) { int R, C; stage_rc(tid * 16 + i * 8192, R, C); const int Rb = (R & ~31) + perm32(R & 31);
        voffA[i] = (unsigned)(R * lda + C) * 2u; voffB[i] = (unsigned)(Rb * K + C) * 2u; }
    unsigned vG[2][2]; int Rg, Cg; stage_rc(tid * 16, Rg, Cg);
    const unsigned c2g = (unsigned)Cg * 2u, rowb = (unsigned)lda * 2u;
    LAS const int* RI = (LAS const int*)(lds + RI_OFF);
    const size_t kstep = (size_t)(BK * 2);
    const size_t hstepA = (size_t)HALF * lda * 2, hstepB = (size_t)HALF * K * 2;
    const size_t tstepA = 2 * hstepA, tstepB = 2 * hstepB;
    const unsigned ldsw = (unsigned)wid * 1024u;
    const int aoff = lds_byte(wr * 64 + fr, fq * 8), boff = lds_byte(wc * 32 + fr, fq * 8);
#define PG8_SA(b, h) (((b) * 2 + (h)) * HTB)
#define PG8_SB(b, h) ((4 + (b) * 2 + (h)) * HTB)
#define PG8_STAGE(bufoff, gbase, voff) do { _Pragma("unroll") for (int _i = 0; _i < 2; ++_i) \
        __builtin_amdgcn_global_load_lds((const unsigned*)((const char*)(gbase) + (voff)[_i]), (LAS unsigned*)(lds + (bufoff) + ldsw + _i * 8192), 16, 0, 0); } while (0)
#define PG8_STAGE_A(bufoff, kptr, h) do { if constexpr (GATHER) PG8_STAGE(bufoff, kptr, vG[h]); else PG8_STAGE(bufoff, (kptr) + (h) * hstepA, voffA); } while (0)
#define PG8_LDA(dst, b, h) do { _Pragma("unroll") for (int m = 0; m < 4; ++m) _Pragma("unroll") for (int k = 0; k < 2; ++k) dst[m][k] = *(const LAS bf16x8*)(lds + PG8_SA(b, h) + aoff + m * 2048 + k * 1024); } while (0)
#define PG8_LDB(dst, b, h) do { _Pragma("unroll") for (int n = 0; n < 2; ++n) _Pragma("unroll") for (int k = 0; k < 2; ++k) dst[n][k] = *(const LAS bf16x8*)(lds + PG8_SB(b, h) + boff + n * 2048 + k * 1024); } while (0)
#define PG8_MMA(ai, bj, At, Bt) do { __builtin_amdgcn_s_setprio(1); _Pragma("unroll") for (int m = 0; m < 4; ++m) _Pragma("unroll") for (int n = 0; n < 2; ++n) _Pragma("unroll") for (int k = 0; k < 2; ++k) \
        acc[ai][bj][m][n] = __builtin_amdgcn_mfma_f32_16x16x32_bf16(Bt[n][k], At[m][k], acc[ai][bj][m][n], 0, 0, 0); __builtin_amdgcn_s_setprio(0); } while (0)
#define PG8_MFMA0(accv, b, a) asm("v_mfma_f32_16x16x32_bf16 %0, %1, %2, 0" : "+v"(accv) : "v"(b), "v"(a))
#define PG8_MMA_F(ai, bj, At, Bt) do { __builtin_amdgcn_s_setprio(1); \
        if (t == 0) { _Pragma("unroll") for (int m = 0; m < 4; ++m) _Pragma("unroll") for (int n = 0; n < 2; ++n) PG8_MFMA0(acc[ai][bj][m][n], Bt[n][0], At[m][0]); } \
        else { _Pragma("unroll") for (int m = 0; m < 4; ++m) _Pragma("unroll") for (int n = 0; n < 2; ++n) acc[ai][bj][m][n] = __builtin_amdgcn_mfma_f32_16x16x32_bf16(Bt[n][0], At[m][0], acc[ai][bj][m][n], 0, 0, 0); } \
        _Pragma("unroll") for (int m = 0; m < 4; ++m) _Pragma("unroll") for (int n = 0; n < 2; ++n) acc[ai][bj][m][n] = __builtin_amdgcn_mfma_f32_16x16x32_bf16(Bt[n][1], At[m][1], acc[ai][bj][m][n], 0, 0, 0); \
        __builtin_amdgcn_s_setprio(0); } while (0)
#define PG8_WAIT_V(n) asm volatile("s_waitcnt vmcnt(" #n ")" ::: "memory")
#define PG8_WAIT_L(n) asm volatile("s_waitcnt lgkmcnt(" #n ")" ::: "memory")
#define PG8_BAR __builtin_amdgcn_s_barrier()
#define PG8_SCHED __builtin_amdgcn_sched_barrier(0)
    Unit cur, nxt; int ui = 0;
    if (!S.next(0, cur)) return;
    f32x4 acc[2][2][4][2];
#pragma unroll
    for (int a = 0; a < 2; ++a)
#pragma unroll
        for (int b = 0; b < 2; ++b)
#pragma unroll
            for (int m = 0; m < 4; ++m)
#pragma unroll
                for (int n = 0; n < 2; ++n) acc[a][b][m][n] = (f32x4){0.f, 0.f, 0.f, 0.f};
    bf16x8 At[4][2], B0[2][2], B1[2][2];
    const char* cA = GATHER ? (const char*)g.A : (const char*)g.A + (size_t)cur.pm * tstepA; const char* cB = (const char*)g.Bt + (size_t)cur.pn * tstepB;
    if constexpr (GATHER) {
#pragma unroll
        for (int h = 0; h < 2; ++h)
#pragma unroll
            for (int i = 0; i < 2; ++i) vG[h][i] = (unsigned)ridx[cur.pm * BM + h * HALF + Rg + 64 * i] * rowb + c2g;
    }
    PG8_STAGE(PG8_SB(0, 0), cB, voffB); PG8_STAGE(PG8_SB(0, 1), cB + hstepB, voffB); PG8_STAGE_A(PG8_SA(0, 0), cA, 0); PG8_STAGE_A(PG8_SA(0, 1), cA, 1);
    if (wr == 1) PG8_BAR;
    PG8_WAIT_V(2); PG8_BAR;
    PG8_STAGE(PG8_SB(1, 0), cB + kstep, voffB); PG8_STAGE_A(PG8_SA(1, 0), cA + kstep, 0); PG8_STAGE(PG8_SB(1, 1), cB + hstepB + kstep, voffB);
    PG8_WAIT_V(6); PG8_BAR;
    for (;;) {
        const bool has_next = S.next(ui + 1, nxt);
        const char* nA = (has_next && !GATHER) ? (const char*)g.A + (size_t)nxt.pm * tstepA : cA;
        if constexpr (GATHER) { const int pmI = has_next ? nxt.pm : cur.pm;
            __builtin_amdgcn_global_load_lds((const unsigned*)(ridx + pmI * BM + (wid & 3) * 64 + lane), (LAS unsigned*)(lds + RI_OFF + (wid & 3) * 256), 4, 0, 0); }
        const char* nB = has_next ? (const char*)g.Bt + (size_t)nxt.pn * tstepB : cB;
        for (int t = 0; t < nt; t += 2) {
            const bool last = (t == nt - 2);
            const char* a1 = cA + (size_t)(t + 1) * kstep;
            const char* a2 = last ? nA : cA + (size_t)(t + 2) * kstep; const char* b2 = last ? nB : cB + (size_t)(t + 2) * kstep;
            const char* a3 = a2 + kstep; const char* b3 = b2 + kstep;
            PG8_LDB(B0, 0, 0); PG8_LDB(B1, 0, 1); PG8_SCHED; PG8_LDA(At, 0, 0); PG8_STAGE_A(PG8_SA(1, 1), a1, 1);
            PG8_WAIT_V(8); PG8_WAIT_L(0); PG8_BAR; PG8_MMA_F(0, 0, At, B0); PG8_MMA_F(0, 1, At, B1); PG8_BAR; PG8_SCHED;
            if constexpr (GATHER) { if (last) {
#pragma unroll
                for (int h = 0; h < 2; ++h)
#pragma unroll
                    for (int i = 0; i < 2; ++i) vG[h][i] = (unsigned)RI[h * HALF + Rg + 64 * i] * rowb + c2g; }
                PG8_SCHED; }
            PG8_LDA(At, 0, 1); PG8_STAGE(PG8_SB(0, 0), b2, voffB); PG8_STAGE(PG8_SB(0, 1), b2 + hstepB, voffB); PG8_STAGE_A(PG8_SA(0, 0), a2, 0);
            PG8_WAIT_V(8); PG8_WAIT_L(0); PG8_BAR; PG8_MMA_F(1, 0, At, B0); PG8_MMA_F(1, 1, At, B1); PG8_BAR; PG8_SCHED;
            PG8_LDB(B0, 1, 0); PG8_LDB(B1, 1, 1); PG8_SCHED; PG8_LDA(At, 1, 0); PG8_STAGE_A(PG8_SA(0, 1), a2, 1);
            PG8_WAIT_V(8); PG8_WAIT_L(0); PG8_BAR; PG8_MMA(0, 0, At, B0); PG8_MMA(0, 1, At, B1); PG8_BAR; PG8_SCHED;
            PG8_LDA(At, 1, 1); PG8_STAGE(PG8_SB(1, 0), b3, voffB); PG8_STAGE(PG8_SB(1, 1), b3 + hstepB, voffB); PG8_STAGE_A(PG8_SA(1, 0), a3, 0);
            PG8_WAIT_V(8); PG8_WAIT_L(0); PG8_BAR; PG8_MMA(1, 0, At, B0); PG8_MMA(1, 1, At, B1); PG8_BAR; PG8_SCHED;
        }
        if constexpr (ALIGN_EPI) { if (wr == 0) PG8_BAR; }
        E(acc, cur, wr, wc, fr, fq);
        if (!has_next) break;
        cur = nxt; cA = nA; cB = nB; ++ui;
        if constexpr (ALIGN_EPI) { if (wr == 1) PG8_BAR; }
    }
    PG8_WAIT_V(0);
    if constexpr (!ALIGN_EPI) { if (wr == 0) PG8_BAR; }
    PG8_BAR;
#undef PG8_SA
#undef PG8_SB
#undef PG8_STAGE
#undef PG8_STAGE_A
#undef PG8_LDA
#undef PG8_LDB
#undef PG8_MMA
#undef PG8_MMA_F
#undef PG8_MFMA0
#undef PG8_WAIT_V
#undef PG8_WAIT_L
#undef PG8_BAR
#undef PG8_SCHED
}
}
namespace fa {
constexpr int SHM_V = 16384, SHM_K = 16384, SHM_KR = 8192;
constexpr int OFF_V = 0, OFF_K = 32768, OFF_KR = 65536, OFF_SCR = 81920, OFF_FLAG = OFF_SCR + 2048, FA_LDS = OFF_FLAG + 64;
#define KSWZ(row, colB) ((row) * 256 + ((colB) ^ (((row) & 7) << 4) ^ ((((row) >> 3) & 1) << 7)))
#define KRSWZ(row, colB) ((row) * 128 + ((colB) ^ ((((row) >> 1) & 7) << 4)))
#define SBAR() __builtin_amdgcn_sched_barrier(0)
__device__ __forceinline__ int v_st(int k, int c) { const int kk = (k & ~0xC) | ((k & 4) << 1) | ((k & 8) >> 1); return ((kk >> 3) * 4 + (c >> 5)) * 512 + ((kk & 7) * 32 + (c & 31)) * 2; }
__device__ __forceinline__ int v_rd_base(int lane) { return ((lane & 3) << 3) | (((lane >> 2) & 3) << 6) | (((lane >> 4) & 1) << 5) | (((lane >> 5) & 1) << 8); }
constexpr int v_rd_off(int d0, int ks, int half) { return d0 * 512 + ks * 4096 + half * 2048; }
__device__ __forceinline__ int crow(int r, int hi) { return (r & 3) + 8 * (r >> 2) + 4 * hi; }

struct AttnArgs {
    const bf16_t* Q; int qpitch, qhs;
    const bf16_t* K; int kpitch, khs;
    const bf16_t* V; int vpitch, vhs;
    const bf16_t* KR; int krpitch;
    bf16_t* O;
    unsigned* flag;
    const float* cosm; const float* sinm;
    const u64* mask;
    int kvdiv;
};

__device__ __forceinline__ void mask_causal(f32x16& p0, f32x16& p1, int dq) {
    const float NEG = -__builtin_inff();
#pragma unroll
    for (int r = 0; r < 16; ++r) { const int c = (r & 3) + 8 * (r >> 2); if (dq - c < 0) p0[r] = NEG; if (dq - c - 32 < 0) p1[r] = NEG; }
}
__device__ __forceinline__ void mask_bits(f32x16& p0, f32x16& p1, u64 mw, int hi) {
    const float NEG = -__builtin_inff();
    const unsigned w0 = (unsigned)mw >> (4 * hi), w1 = (unsigned)(mw >> 32) >> (4 * hi);
#pragma unroll
    for (int r = 0; r < 16; ++r) { const int c = (r & 3) + 8 * (r >> 2);
        const unsigned m0 = (unsigned)__builtin_amdgcn_sbfe((int)w0, c, 1), m1 = (unsigned)__builtin_amdgcn_sbfe((int)w1, c, 1), ninf = __float_as_uint(NEG);
        p0[r] = __uint_as_float(__builtin_amdgcn_bitop3_b32(__float_as_uint(p0[r]), m0, ninf, 0xE2)); p1[r] = __uint_as_float(__builtin_amdgcn_bitop3_b32(__float_as_uint(p1[r]), m1, ninf, 0xE2)); }
}
template <int SCALE_X1E6>
__device__ __forceinline__ void partialSM(f32x16& p0, f32x16& p1, float& m_reg, float& mn, float& alpha) {
    constexpr float SCALE = SCALE_X1E6 * 1e-6f, THR = 8.f;
    float pmax = p0[0];
#pragma unroll
    for (int r = 1; r < 16; ++r) pmax = fmaxf(pmax, p0[r]);
#pragma unroll
    for (int r = 0; r < 16; ++r) pmax = fmaxf(pmax, p1[r]);
    { auto rr = __builtin_amdgcn_permlane32_swap(__float_as_uint(pmax), __float_as_uint(pmax), false, false);
      pmax = fmaxf(__uint_as_float(rr[0]), __uint_as_float(rr[1])); }
    constexpr float C2 = 1.4426950408889634f * SCALE;
    if (__builtin_expect(__all((pmax - m_reg) * SCALE <= THR), 1)) { mn = m_reg; alpha = 1.f; }
    else { mn = fmaxf(m_reg, pmax); alpha = __builtin_amdgcn_exp2f((m_reg - mn) * C2); m_reg = mn; }
    const float mnL = -mn * C2;
#pragma unroll
    for (int r = 0; r < 16; ++r) p0[r] = fmaf(p0[r], C2, mnL);
#pragma unroll
    for (int r = 0; r < 16; ++r) p1[r] = fmaf(p1[r], C2, mnL);
#pragma unroll
    for (int r = 0; r < 16; ++r) p0[r] = __builtin_amdgcn_exp2f(p0[r]);
}
#define PK4(P, B_, OUT) do { unsigned a0 = cvtpk(P[B_+0], P[B_+1]), a1 = cvtpk(P[B_+2], P[B_+3]);                          \
        unsigned b0 = cvtpk(P[B_+4], P[B_+5]), b1 = cvtpk(P[B_+6], P[B_+7]);                                             \
        auto r0 = __builtin_amdgcn_permlane32_swap(a0, b0, false, false); auto r1 = __builtin_amdgcn_permlane32_swap(a1, b1, false, false); \
        u32x4 w = {r0[0], r1[0], r0[1], r1[1]}; OUT = *reinterpret_cast<bf16x8*>(&w); } while (0)
__device__ __forceinline__ void partialSM2(f32x16& p0, f32x16& p1, f32x16& negm, float& m_reg, float& seen, float& alpha) {
    constexpr float THRP = 8.f * 1.4426950408889634f;
    float pmax = p0[0];
#pragma unroll
    for (int r = 1; r < 16; ++r) pmax = fmaxf(pmax, p0[r]);
#pragma unroll
    for (int r = 0; r < 16; ++r) pmax = fmaxf(pmax, p1[r]);
    { auto rr = __builtin_amdgcn_permlane32_swap(__float_as_uint(pmax), __float_as_uint(pmax), false, false);
      pmax = fmaxf(__uint_as_float(rr[0]), __uint_as_float(rr[1])); }
    if (__builtin_expect(__all(seen != 0.f && pmax <= THRP), 1)) { alpha = 1.f; }
    else {
        float d, a;
        if (seen == 0.f) { const bool v = pmax > -__builtin_inff(); d = v ? pmax : 0.f; a = v ? 0.f : 1.f; seen = v ? 1.f : 0.f; }
        else { d = fmaxf(pmax, 0.f); a = __builtin_amdgcn_exp2f(-d); }
        alpha = a; m_reg += d;
#pragma unroll
        for (int r = 0; r < 16; ++r) { p0[r] -= d; p1[r] -= d; }
        const float nm = -m_reg;
#pragma unroll
        for (int r = 0; r < 16; ++r) negm[r] = nm;
    }
#pragma unroll
    for (int r = 0; r < 16; ++r) p0[r] = __builtin_amdgcn_exp2f(p0[r]);
}
__device__ __forceinline__ float fastSM(f32x16& p0, f32x16& p1) {
#pragma unroll
    for (int r = 0; r < 16; ++r) p0[r] = __builtin_amdgcn_exp2f(p0[r]);
#pragma unroll
    for (int r = 0; r < 16; ++r) p1[r] = __builtin_amdgcn_exp2f(p1[r]);
    float ps = 0;
#pragma unroll
    for (int r = 0; r < 16; ++r) ps += p0[r];
#pragma unroll
    for (int r = 0; r < 16; ++r) ps += p1[r];
    { auto rr = __builtin_amdgcn_permlane32_swap(__float_as_uint(ps), __float_as_uint(ps), false, false);
      ps = __uint_as_float(rr[0]) + __uint_as_float(rr[1]); }
    return ps;
}
__device__ __forceinline__ void finishSM(f32x16& p0, f32x16& p1, float alpha, float& l_reg, bf16x8& pa0, bf16x8& pa1, bf16x8& pa2, bf16x8& pa3) {
#pragma unroll
    for (int r = 0; r < 16; ++r) p1[r] = __builtin_amdgcn_exp2f(p1[r]);
    float ps = 0;
#pragma unroll
    for (int r = 0; r < 16; ++r) ps += p0[r];
#pragma unroll
    for (int r = 0; r < 16; ++r) ps += p1[r];
    { auto rr = __builtin_amdgcn_permlane32_swap(__float_as_uint(ps), __float_as_uint(ps), false, false);
      ps = __uint_as_float(rr[0]) + __uint_as_float(rr[1]); }
    l_reg = l_reg * alpha + ps;
    PK4(p0, 0, pa0); PK4(p0, 8, pa1); PK4(p1, 0, pa2); PK4(p1, 8, pa3);
}
__device__ __forceinline__ void sb_tile(f32x16& p0, f32x16& p1, int dq, float& P, bf16x8& pa0, bf16x8& pa1, bf16x8& pa2, bf16x8& pa3, const bool diag) {
    f32x16 f0, f1;
#pragma unroll
    for (int r = 0; r < 16; ++r) {
        { const float e = __builtin_amdgcn_exp2f(-p0[r]); const float rr = __builtin_amdgcn_rcpf(1.0f + e); f0[r] = 1.0f - rr; p0[r] = rr; }
        { const float e = __builtin_amdgcn_exp2f(-p1[r]); const float rr = __builtin_amdgcn_rcpf(1.0f + e); f1[r] = 1.0f - rr; p1[r] = rr; } }
    if (diag) { asm volatile("" ::: "memory");
#pragma unroll
        for (int r = 0; r < 16; ++r) { const int c = (r & 3) + 8 * (r >> 2); f0[r] = (dq - c > 0) ? f0[r] : 1.0f; f1[r] = (dq - c - 32 > 0) ? f1[r] : 1.0f; } }
    float S[16];
#pragma unroll
    for (int i = 0; i < 4; ++i) {
        const float g0 = (f0[4 * i] * f0[4 * i + 1]) * (f0[4 * i + 2] * f0[4 * i + 3]);
        const float g1 = (f1[4 * i] * f1[4 * i + 1]) * (f1[4 * i + 2] * f1[4 * i + 3]);
        auto r0 = __builtin_amdgcn_permlane32_swap(__float_as_uint(g0), __float_as_uint(g0), false, false);
        auto r1 = __builtin_amdgcn_permlane32_swap(__float_as_uint(g1), __float_as_uint(g1), false, false);
        S[2 * i] = __uint_as_float(r0[0]); S[2 * i + 1] = __uint_as_float(r0[1]);
        S[8 + 2 * i] = __uint_as_float(r1[0]); S[8 + 2 * i + 1] = __uint_as_float(r1[1]); }
    float Tg[16]; Tg[15] = 1.0f;
#pragma unroll
    for (int g = 14; g >= 0; --g) Tg[g] = Tg[g + 1] * S[g + 1];
    const float total = Tg[0] * S[0];
    const bool up = (__lane_id() & 32) != 0;
#pragma unroll
    for (int i = 0; i < 4; ++i) {
        { float t = P * Tg[2 * i + 1] * (up ? 1.0f : S[2 * i + 1]);
#pragma unroll
          for (int j = 3; j >= 0; --j) { const int r = 4 * i + j; const float a = p0[r] * t; t *= f0[r]; p0[r] = a; } }
        { float t = P * Tg[8 + 2 * i + 1] * (up ? 1.0f : S[8 + 2 * i + 1]);
#pragma unroll
          for (int j = 3; j >= 0; --j) { const int r = 4 * i + j; const float a = p1[r] * t; t *= f1[r]; p1[r] = a; } }
    }
    if (diag) { asm volatile("" ::: "memory");
#pragma unroll
        for (int r = 0; r < 16; ++r) { const int c = (r & 3) + 8 * (r >> 2); p0[r] = (dq - c > 0) ? p0[r] : 0.f; p1[r] = (dq - c - 32 > 0) ? p1[r] : 0.f; } }
    P *= total;
    PK4(p0, 0, pa0); PK4(p0, 8, pa1); PK4(p1, 0, pa2); PK4(p1, 8, pa3);
}
template <int KB, int NQ>
__device__ __forceinline__ void qkt(f32x16& p0, f32x16& p1, LAS unsigned char* lds, int r32, int hi, const bf16x8* qr, const f32x16& c0) {
    const int lb = (int)(unsigned)(uintptr_t)lds;
    int ka[8], kra[(NQ > 8) ? 4 : 1];
#pragma unroll
    for (int d0 = 0; d0 < 8; ++d0) ka[d0] = lb + KSWZ(r32, (d0 * 16 + hi * 8) * 2);
    if constexpr (NQ > 8) {
#pragma unroll
        for (int d0 = 0; d0 < 4; ++d0) kra[d0] = lb + OFF_KR + KRSWZ(r32, (d0 * 16 + hi * 8) * 2); }
    bf16x8 fa[3], fb[3];
#define KRD(dst, addr, off) asm volatile("ds_read_b128 %0, %1 offset:%2" : "=&v"(dst) : "v"(addr), "i"(off) : "memory")
#define QK_RD(d0) do { if constexpr ((d0) < 8) { KRD(fa[(d0) % 3], ka[(d0) < 8 ? (d0) : 0], OFF_K + KB * SHM_K); KRD(fb[(d0) % 3], ka[(d0) < 8 ? (d0) : 0], OFF_K + KB * SHM_K + 32 * 256); } \
                       else { KRD(fa[(d0) % 3], kra[(d0) >= 8 && NQ > 8 ? (d0) - 8 : 0], KB * SHM_KR); KRD(fb[(d0) % 3], kra[(d0) >= 8 && NQ > 8 ? (d0) - 8 : 0], KB * SHM_KR + 32 * 128); } } while (0)
#define QK_STEP(d0) do { if constexpr ((d0) < NQ) {                                                                              \
        if constexpr ((d0) + 2 < NQ) asm volatile("s_waitcnt lgkmcnt(4)" ::: "memory");                                          \
        else if constexpr ((d0) + 1 < NQ) asm volatile("s_waitcnt lgkmcnt(2)" ::: "memory");                                     \
        else asm volatile("s_waitcnt lgkmcnt(0)" ::: "memory");                                                                  \
        SBAR();                                                                                                                  \
        if constexpr ((d0) == 0) { p0 = __builtin_amdgcn_mfma_f32_32x32x16_bf16(fa[0], qr[0], c0, 0, 0, 0); p1 = __builtin_amdgcn_mfma_f32_32x32x16_bf16(fb[0], qr[0], c0, 0, 0, 0); }   \
        else { p0 = __builtin_amdgcn_mfma_f32_32x32x16_bf16(fa[(d0) % 3], qr[(d0) < NQ ? (d0) : 0], p0, 0, 0, 0);                \
               p1 = __builtin_amdgcn_mfma_f32_32x32x16_bf16(fb[(d0) % 3], qr[(d0) < NQ ? (d0) : 0], p1, 0, 0, 0); }              \
        SBAR();                                                                                                                  \
        if constexpr ((d0) + 3 < NQ) QK_RD((d0) + 3); } } while (0)
    QK_RD(0); QK_RD(1); QK_RD(2);
    QK_STEP(0); QK_STEP(1); QK_STEP(2); QK_STEP(3); QK_STEP(4); QK_STEP(5); QK_STEP(6); QK_STEP(7); QK_STEP(8); QK_STEP(9); QK_STEP(10); QK_STEP(11);
#undef QK_STEP
#undef QK_RD
#undef KRD
}
template <int VB>
__device__ __forceinline__ void pv_tile(f32x16* o, int vb0, bf16x8 pa0, bf16x8 pa1, bf16x8 pa2, bf16x8 pa3) {
#define TRRD(dst, off) asm volatile("ds_read_b64_tr_b16 %0, %1 offset:%2" : "=&v"(dst) : "v"(vb0), "i"(off) : "memory")
#define PV_RD(S, d0) do { constexpr int b_ = OFF_V + VB * SHM_V + v_rd_off(d0, 0, 0); \
        TRRD(S##l0, b_); TRRD(S##h0, b_ + 2048); TRRD(S##l1, b_ + 4096); TRRD(S##h1, b_ + 6144); TRRD(S##l2, b_ + 8192); TRRD(S##h2, b_ + 10240); TRRD(S##l3, b_ + 12288); TRRD(S##h3, b_ + 14336); } while (0)
#define PV_MM(S, d0) do { \
        o[d0] = __builtin_amdgcn_mfma_f32_32x32x16_bf16(pa0, (bf16x8){S##l0[0], S##l0[1], S##l0[2], S##l0[3], S##h0[0], S##h0[1], S##h0[2], S##h0[3]}, o[d0], 0, 0, 0);   \
        o[d0] = __builtin_amdgcn_mfma_f32_32x32x16_bf16(pa1, (bf16x8){S##l1[0], S##l1[1], S##l1[2], S##l1[3], S##h1[0], S##h1[1], S##h1[2], S##h1[3]}, o[d0], 0, 0, 0);   \
        o[d0] = __builtin_amdgcn_mfma_f32_32x32x16_bf16(pa2, (bf16x8){S##l2[0], S##l2[1], S##l2[2], S##l2[3], S##h2[0], S##h2[1], S##h2[2], S##h2[3]}, o[d0], 0, 0, 0);   \
        o[d0] = __builtin_amdgcn_mfma_f32_32x32x16_bf16(pa3, (bf16x8){S##l3[0], S##l3[1], S##l3[2], S##l3[3], S##h3[0], S##h3[1], S##h3[2], S##h3[3]}, o[d0], 0, 0, 0); } while (0)
#define PV_W(n) do { asm volatile("s_waitcnt lgkmcnt(" #n ")" ::: "memory"); SBAR(); } while (0)
    s16x4 Al0, Al1, Al2, Al3, Ah0, Ah1, Ah2, Ah3, Bl0, Bl1, Bl2, Bl3, Bh0, Bh1, Bh2, Bh3;
    PV_RD(A, 0); PV_RD(B, 1); PV_W(8); PV_MM(A, 0); SBAR();
    PV_RD(A, 2); PV_W(8); PV_MM(B, 1); SBAR();
    PV_RD(B, 3); PV_W(8); PV_MM(A, 2); SBAR();
    PV_W(0); PV_MM(B, 3);
#undef PV_W
#undef PV_MM
#undef PV_RD
#undef TRRD
}

template <int MODE, bool FAST = false>
__device__ __forceinline__ void attn_unit(LAS unsigned char* lds, const AttnArgs& A, int b, int h, int qb) {
    constexpr int NQ = (MODE == 1) ? 12 : 8;
    constexpr int SCALE6 = (MODE == 1) ? 72169 : 88388;
    const int tid = opaque_tid(), wid = __builtin_amdgcn_readfirstlane(tid >> 6), lane = tid & 63, r32 = lane & 31, hi = lane >> 5;
    const int q0 = qb * 256, qw0 = q0 + wid * 32, qpos = qw0 + r32;
    const size_t tok0 = (size_t)b * SEQ;
    LAS float* wsf = (LAS float*)(lds + OFF_SCR) + wid * 64; LAS float* li_l = wsf; LAS float* al_l = wsf + 32;
    volatile LAS int* flg = (volatile LAS int*)(lds + OFF_FLAG);
    bf16x8 qr[NQ];
    { const bf16_t* qrow = A.Q + (tok0 + qpos) * (size_t)A.qpitch + (size_t)h * A.qhs + hi * 8;
#pragma unroll
      for (int d0 = 0; d0 < NQ; ++d0) qr[d0] = *(const bf16x8*)(qrow + d0 * 16); }
    constexpr float QC2 = 1.4426950408889634f * (SCALE6 * 1e-6f);
    {
#pragma unroll
        for (int d0 = 0; d0 < 8; ++d0) { const u32x4 x = *reinterpret_cast<u32x4*>(&qr[d0]); u32x4 y;
#pragma unroll
            for (int w = 0; w < 4; ++w) y[w] = cvtpk(bflo(x[w]) * QC2, bfhi(x[w]) * QC2);
            qr[d0] = *reinterpret_cast<bf16x8*>(&y); }
    }
    if constexpr (MODE == 1) {
        const float* cs = A.cosm + (tok0 + qpos) * 32 + hi * 8; const float* sn = A.sinm + (tok0 + qpos) * 32 + hi * 8;
#pragma unroll
        for (int c2 = 0; c2 < 2; ++c2) {
            const f32x4 ca = *(const f32x4*)(cs + 16 * c2), cb = *(const f32x4*)(cs + 16 * c2 + 4), sa = *(const f32x4*)(sn + 16 * c2), sb = *(const f32x4*)(sn + 16 * c2 + 4);
            const u32x4 x1 = *reinterpret_cast<u32x4*>(&qr[8 + c2]), x2 = *reinterpret_cast<u32x4*>(&qr[10 + c2]);
            u32x4 y1, y2;
#pragma unroll
            for (int w = 0; w < 4; ++w) {
                const float c0 = (w < 2) ? ca[2 * w] : cb[2 * w - 4], c1 = (w < 2) ? ca[2 * w + 1] : cb[2 * w - 3];
                const float s0 = (w < 2) ? sa[2 * w] : sb[2 * w - 4], s1 = (w < 2) ? sa[2 * w + 1] : sb[2 * w - 3];
                const float a0 = bflo(x1[w]), a1 = bfhi(x1[w]), b0 = bflo(x2[w]), b1 = bfhi(x2[w]);
                y1[w] = cvtpk((a0 * c0 - b0 * s0) * QC2, (a1 * c1 - b1 * s1) * QC2); y2[w] = cvtpk((b0 * c0 + a0 * s0) * QC2, (b1 * c1 + a1 * s1) * QC2); }
            qr[8 + c2] = *reinterpret_cast<bf16x8*>(&y1); qr[10 + c2] = *reinterpret_cast<bf16x8*>(&y2); }
    }
    const int kvh = h / A.kvdiv;
    const bf16_t* Kg = A.K + (size_t)kvh * A.khs; const bf16_t* Vg = A.V + (size_t)kvh * A.vhs;
    int koff[2], voff[2], kroff = 0;
#pragma unroll
    for (int i = 0; i < 2; ++i) { const int q = (wid * 2 + i) * 1024 + lane * 16;
        { const int row = q >> 8, colB = (q & 255) ^ ((row & 7) << 4) ^ (((row >> 3) & 1) << 7); koff[i] = row * A.kpitch + (colB >> 1); }
        { const int st = q >> 9, kk = ((st >> 2) << 3) | ((q & 511) >> 6), k = (kk & ~0xC) | ((kk & 4) << 1) | ((kk & 8) >> 1), c = (st & 3) * 32 + ((q & 63) >> 1); voff[i] = k * A.vpitch + c; } }
    if constexpr (MODE == 1) { const int q = wid * 1024 + lane * 16, row = q >> 7, colB = (q & 127) ^ (((row >> 1) & 7) << 4); kroff = row * A.krpitch + (colB >> 1); }
    const int vb0 = (int)(unsigned)(uintptr_t)lds + v_rd_base(lane);
    u64 mw_cur = 0, mw_nxt = 0;
    const u64* mrow = nullptr;
    if constexpr (MODE == 2) mrow = A.mask + (size_t)b * 128 * SEQ;
    const unsigned mqoff = (unsigned)qpos * 8u;
#define GLDS(src, dst) __builtin_amdgcn_global_load_lds((const unsigned*)(src), (LAS unsigned*)(dst), 16, 0, 0)
    const __amdgpu_buffer_rsrc_t rsK = __builtin_amdgcn_make_buffer_rsrc((void*)Kg, 0, 0x7fffffff, 0x00020000), rsV = __builtin_amdgcn_make_buffer_rsrc((void*)Vg, 0, 0x7fffffff, 0x00020000);
    const __amdgpu_buffer_rsrc_t rsR = __builtin_amdgcn_make_buffer_rsrc((void*)((MODE == 1) ? A.KR : Kg), 0, 0x7fffffff, 0x00020000);
#define BLDS(rs, soff, voff, dst) __builtin_amdgcn_raw_ptr_buffer_load_lds(rs, (LAS void*)(dst), 16, (int)(voff), (int)(soff), 0, 0)
    constexpr bool SREG = false;
    u32x4 sk[2], sv[2], skr;
#define LOADT(j, bf) do { const size_t t0_ = tok0 + (size_t)(j) * 64;                                                           \
        _Pragma("unroll") for (int i_ = 0; i_ < 2; ++i_) {                                                                      \
            if constexpr (SREG) { sk[i_] = *(const u32x4*)(Kg + t0_ * A.kpitch + koff[i_]); sv[i_] = *(const u32x4*)(Vg + t0_ * A.vpitch + voff[i_]); } \
            else { BLDS(rsK, (unsigned)t0_ * (unsigned)A.kpitch * 2u, (unsigned)(koff[i_] * 2), lds + OFF_K + (bf) * SHM_K + (wid * 2 + i_) * 1024);   \
                   BLDS(rsV, (unsigned)t0_ * (unsigned)A.vpitch * 2u, (unsigned)(voff[i_] * 2), lds + OFF_V + (bf) * SHM_V + (wid * 2 + i_) * 1024); } }   \
        if constexpr (MODE == 1) { if constexpr (SREG) skr = *(const u32x4*)(A.KR + t0_ * A.krpitch + kroff); else BLDS(rsR, (unsigned)t0_ * (unsigned)A.krpitch * 2u, (unsigned)(kroff * 2), lds + OFF_KR + (bf) * SHM_KR + wid * 1024); } \
        if constexpr (MODE == 2) mw_nxt = *(const u64*)((const char*)(mrow + (size_t)(j) * SEQ) + mqoff); } while (0)
#define WRITET(bf) do { if constexpr (SREG) {                                                                                   \
        _Pragma("unroll") for (int i_ = 0; i_ < 2; ++i_) {                                                                      \
            *(LAS u32x4*)(lds + OFF_K + (bf) * SHM_K + (wid * 2 + i_) * 1024 + lane * 16) = sk[i_];                             \
            *(LAS u32x4*)(lds + OFF_V + (bf) * SHM_V + (wid * 2 + i_) * 1024 + lane * 16) = sv[i_]; }                           \
        if constexpr (MODE == 1) *(LAS u32x4*)(lds + OFF_KR + (bf) * SHM_KR + wid * 1024 + lane * 16) = skr; } } while (0)
    const int NT = 4 * qb + 4;
    bool bad = false;
    float m_reg = (MODE == 0) ? -1e30f : 0.f, l_reg = 0.f, Rsb = 1.0f, seen = 0.f; f32x16 o[4] = {}; f32x16 negm = {};
#define TILE_OF(it) ((MODE == 0) ? (NT - 1 - (it)) : (it))
    LOADT(TILE_OF(0), 0); mw_cur = mw_nxt; WRITET(0);
    VM_WAIT(); __syncthreads();
    bool stop = false;
#define STEP(BUF, it) do {                                                                                                      \
        const int j_ = TILE_OF(it), kb_ = j_ * 64; const bool more_ = (it) + 1 < NT;                                            \
        if (more_) LOADT(TILE_OF((it) + 1), (BUF) ^ 1);                                                                         \
        SBAR();                                                                                                                 \
        const bool act_ = (MODE == 0) ? (kb_ <= qw0 + 30 && !__all(Rsb < 1e-37f)) : (kb_ <= qw0 + 31);     \
        if (act_) {                                                                                                             \
            f32x16 p0, p1; bf16x8 pa0, pa1, pa2, pa3;                                                                           \
            qkt<BUF, NQ>(p0, p1, lds, r32, hi, qr, negm);                                                                       \
            if constexpr (MODE == 0) { sb_tile(p0, p1, qpos - kb_ - 4 * hi, Rsb, pa0, pa1, pa2, pa3, kb_ + 63 > qw0); }                \
            else { float mn_, al_;                                                                                              \
                if constexpr (MODE == 1) { if (kb_ + 63 > qw0) { asm volatile("" ::: "memory");     mask_causal(p0, p1, qpos - kb_ - 4 * hi); } }                      \
                else mask_bits(p0, p1, mw_cur, hi);                                                                             \
                if constexpr (FAST) { const float ps_ = fastSM(p0, p1); bad = bad || !(ps_ < 1.1529215e18f); l_reg += ps_; (void)mn_; (void)al_;   \
                    PK4(p0, 0, pa0); PK4(p0, 8, pa1); PK4(p1, 0, pa2); PK4(p1, 8, pa3); }                                       \
                else { partialSM2(p0, p1, negm, m_reg, seen, al_); (void)mn_; finishSM(p0, p1, al_, l_reg, pa0, pa1, pa2, pa3); \
                    if (__any(al_ < 1.f)) { if (hi == 0) al_l[r32] = al_; LDS_WAIT();                                           \
                        _Pragma("unroll") for (int d_ = 0; d_ < 4; ++d_) _Pragma("unroll") for (int r = 0; r < 16; ++r) o[d_][r] *= al_l[crow(r, hi)]; } } }   \
            SBAR(); pv_tile<BUF>(o, vb0, pa0, pa1, pa2, pa3);                                                                   \
        }                                                                                                                       \
        SBAR();                                                                                                                 \
        if (more_) { WRITET((BUF) ^ 1); mw_cur = mw_nxt; }                                                                      \
        if constexpr (MODE == 0) { const bool fin_ = __all(Rsb < 1e-37f) != 0; if (lane == 0) flg[((it) & 1) * 8 + wid] = fin_ ? 1 : 0; }   \
        VM_WAIT(); __syncthreads();                                                                                             \
        if constexpr (MODE == 0) { int all_ = 1; _Pragma("unroll") for (int w_ = 0; w_ < 8; ++w_) all_ &= flg[((it) & 1) * 8 + w_]; stop = all_ != 0; }   \
    } while (0)
    for (int it = 0; it < NT; it += 2) {
        STEP(0, it); if (stop) break;
        if (it + 1 < NT) { STEP(1, it + 1); if (stop) break; }
    }
#undef STEP
#undef LOADT
#undef WRITET
#undef GLDS
#undef BLDS
#undef TILE_OF
    if constexpr (MODE != 0 && FAST) {
        bad = bad || !(l_reg > 8.6736174e-19f);
        if (__any(bad) && lane == 0) __hip_atomic_store(A.flag, 1u, __ATOMIC_RELAXED, __HIP_MEMORY_SCOPE_AGENT);
    }
    float rli[16];
    if constexpr (MODE != 0) {
        if (hi == 0) li_l[r32] = l_reg; LDS_WAIT();
#pragma unroll
        for (int r = 0; r < 16; ++r) rli[r] = __builtin_amdgcn_rcpf(li_l[crow(r, hi)]);
    }
    bf16_t* Ow = A.O + (tok0 + qw0) * 1024 + (size_t)h * 128;
    LAS unsigned char* stg = lds + wid * (32 * 272);
#pragma unroll
    for (int r = 0; r < 16; ++r) { const int orow = crow(r, hi);
#pragma unroll
        for (int d0 = 0; d0 < 4; ++d0) { float v = o[d0][r]; if constexpr (MODE != 0) v *= rli[r];
            *(LAS unsigned short*)(stg + orow * 272 + (d0 * 32 + r32) * 2) = (unsigned short)(cvtpk(v, 0.f) & 0xffffu); } }
    LDS_WAIT();
#pragma unroll
    for (int i = 0; i < 8; ++i) { const int row = 4 * i + (lane >> 4), ch = lane & 15;
        const u32x4 w = *(const LAS u32x4*)(stg + row * 272 + ch * 16);
        *(u32x4*)(Ow + (size_t)row * 1024 + ch * 8) = w; }
    LDS_BARRIER();
}

template <int MODE, bool FAST = false>
__device__ __forceinline__ void attn_phase(LAS unsigned char* lds, const AttnArgs& A, int vcu, int G) {
    constexpr int NITEM = NB * 8 * 16;
    for (int L = vcu; L < NITEM; L += G) {
        const int bh = L >> 4, x = L & 15, b = bh >> 3, h = bh & 7;
        attn_unit<MODE, FAST>(lds, A, b, h, 31 - x);
        attn_unit<MODE, FAST>(lds, A, b, h, x);
    }
}
}
__device__ __forceinline__ void transpose_item(const float* W, int K, int N, bf16_t* WT, int Kp, int mode, int F, LAS float* scr, int item, int lane) {
    const int nblk = (N + 31) >> 5, kb = item / nblk, nb = item - kb * nblk, k0 = 64 * kb, n0 = 32 * nb;
    int nn = n0 + (lane & 31); if (nn > N - 1) nn = N - 1;
#pragma unroll 8
    for (int i = 0; i < 32; ++i) { const int kk = 2 * i + (lane >> 5); scr[kk * 33 + (lane & 31)] = W[(size_t)(k0 + kk) * N + nn]; }
    LDS_WAIT(); asm volatile("" ::: "memory");
    const int c = lane & 7;
#pragma unroll
    for (int j = 0; j < 4; ++j) { const int n = (lane >> 3) + 8 * j; const LAS float* s = scr + (8 * c) * 33 + n;
        int row = n0 + n;
        if (mode == 1) { const int mloc = row < F ? row : row - F; row = (mloc >> 7) * 256 + (mloc & 127) + (row < F ? 0 : 128); }
        u32x4 o; o.x = cvtpk(s[0 * 33], s[1 * 33]); o.y = cvtpk(s[2 * 33], s[3 * 33]); o.z = cvtpk(s[4 * 33], s[5 * 33]); o.w = cvtpk(s[6 * 33], s[7 * 33]);
        *(u32x4*)(WT + (size_t)row * Kp + k0 + 8 * c) = o; }
    LDS_WAIT(); asm volatile("" ::: "memory");
}
struct WDesc { const float* src; bf16_t* dst; int nmat, K, N, Kp, mode, F, npad; };
__device__ __forceinline__ int wdesc_items(const WDesc& d) { return d.nmat * (d.K >> 6) * ((d.N + 31) >> 5); }

__device__ __forceinline__ void prologue_phase(LAS unsigned char* lds, const float* const* in, const int* positions, unsigned char* ws, int vcu, int G) {
    const int tid = opaque_tid(), lane = tid & 63, wave = __builtin_amdgcn_readfirstlane(tid >> 6);
    {
        LAS float* cond = (LAS float*)lds;
        LAS float* red = (LAS float*)(lds + 16384);
        const float* c = in[1]; const float* ada_w = in[3]; const float* ada_b = in[4]; float* MOD = (float*)(ws + WS_MOD);
        bool have = false;
        for (int item = vcu; item < 96; item += G) {
            if (!have) { for (int u = tid; u < 4096; u += 512) { const float v = c[u]; cond[u] = v / (1.0f + __expf(-v)); } have = true; }
            __syncthreads();
            const int l = item / 24, ct = item - l * 24;
            f32x4 acc[4];
#pragma unroll
            for (int b = 0; b < 4; ++b) acc[b] = (f32x4){0.f, 0.f, 0.f, 0.f};
            const float* wp = ada_w + ((size_t)l * 1024 + wave * 128) * 6144 + ct * 256 + 4 * lane;
#pragma unroll 8
            for (int k = 0; k < 128; ++k) { const f32x4 wv = *(const f32x4*)(wp + (size_t)k * 6144);
#pragma unroll
                for (int b = 0; b < 4; ++b) acc[b] += wv * cond[b * 1024 + wave * 128 + k]; }
#pragma unroll
            for (int b = 0; b < 4; ++b) *(LAS f32x4*)(red + ((wave * 4 + b) * 256 + 4 * lane)) = acc[b];
            __syncthreads();
#pragma unroll
            for (int h2 = 0; h2 < 2; ++h2) { const int idx = tid + 512 * h2, b = idx >> 8, col = idx & 255; float s = ada_b[l * 6144 + ct * 256 + col];
#pragma unroll
                for (int w = 0; w < 8; ++w) s += red[(w * 4 + b) * 256 + col];
                MOD[((size_t)l * 4 + b) * 6144 + ct * 256 + col] = s; }
            __syncthreads();
        }
        __syncthreads();
    }
    {
        LAS float* scr = (LAS float*)(lds + wave * 16384);
        const int gw = vcu * NWAVES + wave, NGW = G * NWAVES;
        WDesc D[12];
        D[0] = WDesc{in[6], (bf16_t*)(ws + W_SBIN), 2, 1024, SBW, 1024, 0, 0, SBW};
        D[1] = WDesc{in[7], (bf16_t*)(ws + W_SBOUT), 2, 1024, 1024, 1024, 0, 0, 1024};
        D[2] = WDesc{in[8], (bf16_t*)(ws + W_MLAIN), 1, 1024, MLAW_REAL, 1024, 0, 0, MLAW};
        D[3] = WDesc{in[10], (bf16_t*)(ws + W_MLAQ), 1, 256, 1536, 256, 0, 0, 1536};
        D[4] = WDesc{in[12], (bf16_t*)(ws + W_MLAKV), 1, 128, 2048, 128, 0, 0, 2048};
        D[5] = WDesc{in[13], (bf16_t*)(ws + W_MLAOUT), 1, 1024, 1024, 1024, 0, 0, 1024};
        D[6] = WDesc{in[14], (bf16_t*)(ws + W_DSAIN), 1, 1024, DSAW_REAL, 1024, 0, 0, DSAW};
        D[7] = WDesc{in[16], (bf16_t*)(ws + W_DSAOUT), 1, 1024, 1024, 1024, 0, 0, 1024};
        D[8] = WDesc{in[17], (bf16_t*)(ws + W_FFNGU), 2, 1024, 2 * DFF, 1024, 1, DFF, 2 * DFF};
        D[9] = WDesc{in[18], (bf16_t*)(ws + W_FFNDN), 2, DFF, 1024, DFF, 0, 0, 1024};
        D[10] = WDesc{in[21], (bf16_t*)(ws + W_MOEGU), 16, 1024, 2 * DFFE, 1024, 1, DFFE, 2 * DFFE};
        D[11] = WDesc{in[22], (bf16_t*)(ws + W_MOEDN), 16, DFFE, 1024, DFFE, 0, 0, 1024};
        int total = 0;
#pragma unroll
        for (int d = 0; d < 12; ++d) total += wdesc_items(D[d]);
        for (int it = gw; it < total; it += NGW) {
            int r = it; const float* src = nullptr; bf16_t* dst = nullptr; int K = 0, N = 0, Kp = 0, mode = 0, F = 0; bool found = false;
#pragma unroll
            for (int d = 0; d < 12; ++d) { const int ni = wdesc_items(D[d]);
                if (!found) { if (r < ni) { const int per = ni / D[d].nmat, mi = r / per; r -= mi * per;
                        src = D[d].src + (size_t)mi * D[d].K * D[d].N; dst = D[d].dst + (size_t)mi * D[d].npad * D[d].Kp; K = D[d].K; N = D[d].N; Kp = D[d].Kp; mode = D[d].mode; F = D[d].F; found = true; }
                    else r -= ni; } }
            transpose_item(src, K, N, dst, Kp, mode, F, scr, r, lane);
        }
        float* cosm = (float*)(ws + RP_COSM); float* sinm = (float*)(ws + RP_SINM); float* cosa = (float*)(ws + RP_COSA); float* sina = (float*)(ws + RP_SINA);
        float* cosi = (float*)(ws + RP_COSI); float* sini = (float*)(ws + RP_SINI);
        int j = lane, rot = 64; float* ct = cosm; float* stb = sinm; int nf = 32;
        if (lane >= 48) { j = lane - 48; rot = 16; ct = cosi; stb = sini; nf = 8; }
        else if (lane >= 32) { j = lane - 32; rot = 32; ct = cosa; stb = sina; nf = 16; }
        const float inv = (float)exp2(-((double)(2 * j) / (double)rot) * 18.931568569324174);
        for (int m = gw; m < NTOK; m += NGW) {
            const float ang = (float)positions[m] * inv;
            double rev = (double)ang * 0.15915494309189535; rev -= floor(rev);
            const float rf = (float)rev;
            if (lane < 56) { ct[(size_t)m * nf + j] = __builtin_amdgcn_cosf(rf); stb[(size_t)m * nf + j] = __builtin_amdgcn_sinf(rf); }
        }
    }
}

struct ThinArgs {
    const float* xsrc; const bf16_t* xsrc16; float* xdst; bf16_t* xdst16; const bf16_t* H; bf16_t* Hout;
    int has_y, ymode, has_next, router;
    const float* gate; const float* gpost;
    const float* nsc; const float* nsh; const float* gpre;
    const bf16_t* OUTR; const int* SLOT; const float* GATEV;
    const float* wr; const float* br; int* SEL; float* GATEO; int* CCNT;
};
#ifndef THIN_DEEP_SEL
#define THIN_DEEP_SEL false
#endif
template <bool X32, bool HAS_Y, int YMODE, bool HAS_NEXT, bool ROUTER, bool XDST32>
__device__ __forceinline__ void thin_phase(LAS unsigned char* lds, const ThinArgs& A, int vcu, int G) {
    const int tid = opaque_tid(), lane = tid & 63, wave = __builtin_amdgcn_readfirstlane(tid >> 6);
    constexpr bool THIN_DEEP = THIN_DEEP_SEL;
    LAS float* Wt = (LAS float*)lds;
    LAS int* lcnt = (LAS int*)(lds + 32768);
    if (ROUTER) { for (int u = tid; u < 8192; u += 512) { const int k = u >> 3, e = u & 7; Wt[e * 1024 + k] = A.wr[u]; } }
    for (int gwi = vcu * NWAVES + wave; gwi < NTOK / 16; gwi += G * NWAVES) {
        if (ROUTER) { if (tid < 8) lcnt[tid] = 0; __syncthreads(); }
        const int m0 = gwi * 16, b = m0 >> 13;
        f32x4 q1[4], q2[4], q3[4], q4[4], q5[4];
#pragma unroll
        for (int j = 0; j < 4; ++j) { const int col = 4 * lane + 256 * j;
            if (HAS_Y) { q1[j] = *(const f32x4*)(A.gate + (size_t)b * 6144 + col); q2[j] = *(const f32x4*)(A.gpost + col); }
            if (HAS_NEXT) { q3[j] = *(const f32x4*)(A.gpre + col); q4[j] = *(const f32x4*)(A.nsc + (size_t)b * 6144 + col); q5[j] = *(const f32x4*)(A.nsh + (size_t)b * 6144 + col); } }
        f32x4 a1[4], a2[4], a3[4];
        int sl0 = 0, sl1 = 0; float gg0 = 0.f, gg1 = 0.f;
        if (HAS_Y && YMODE == 1 && lane < 16) { sl0 = A.SLOT[2 * (m0 + lane)]; sl1 = A.SLOT[2 * (m0 + lane) + 1]; gg0 = A.GATEV[2 * (m0 + lane)]; gg1 = A.GATEV[2 * (m0 + lane) + 1]; }
        float brv[8];
#pragma unroll
        for (int e = 0; e < 8; ++e) brv[e] = ROUTER ? A.br[e] : 0.f;
        f32x4 nxfA[4], nxfB[4], nxfC[4], nxfD[4]; u32x2 nxhA[4], nxhB[4], nxhC[4], nxhD[4], ny0A[4], ny0B[4], ny0C[4], ny0D[4], ny1A[4], ny1B[4], ny1C[4], ny1D[4];
#define THIN_LOAD(P, rr_) do { const int r_ = (rr_) < 15 ? (rr_) : 15; const int m_ = m0 + r_;                                  \
            _Pragma("unroll") for (int j = 0; j < 4; ++j) {                                                                     \
                if (X32) nxf##P[j] = *(const f32x4*)(A.xsrc + (size_t)m_ * 1024 + 4 * lane + 256 * j);                       \
                else nxh##P[j] = *(const u32x2*)(A.xsrc16 + (size_t)m_ * 1024 + 4 * lane + 256 * j); }                          \
            if (HAS_Y) { if (YMODE == 0) { _Pragma("unroll") for (int j = 0; j < 4; ++j) ny0##P[j] = *(const u32x2*)(A.H + (size_t)m_ * 1024 + 4 * lane + 256 * j); }   \
                else { const int s0_ = __builtin_amdgcn_readlane(sl0, r_), s1_ = __builtin_amdgcn_readlane(sl1, r_);             \
                    _Pragma("unroll") for (int j = 0; j < 4; ++j) { ny0##P[j] = *(const u32x2*)(A.OUTR + (size_t)s0_ * 1024 + 4 * lane + 256 * j); ny1##P[j] = *(const u32x2*)(A.OUTR + (size_t)s1_ * 1024 + 4 * lane + 256 * j); } } } } while (0)
#define THIN_TAKE(P) do { _Pragma("unroll") for (int j = 0; j < 4; ++j) { if (X32) x[j] = nxf##P[j]; else x[j] = (f32x4){bflo(nxh##P[j].x), bfhi(nxh##P[j].x), bflo(nxh##P[j].y), bfhi(nxh##P[j].y)}; cy0[j] = ny0##P[j]; cy1[j] = ny1##P[j]; } } while (0)
        auto thin_row = [&](const int rr, f32x4 (&x)[4], const u32x2 (&cy0)[4], const u32x2 (&cy1)[4]) __attribute__((always_inline)) {
            const int m = m0 + rr;
            if (HAS_Y) {
                f32x4 y[4];
                if (YMODE == 0) {
#pragma unroll
                    for (int j = 0; j < 4; ++j) y[j] = (f32x4){bflo(cy0[j].x), bfhi(cy0[j].x), bflo(cy0[j].y), bfhi(cy0[j].y)};
                } else {
                    const float g0 = __uint_as_float(__builtin_amdgcn_readlane(__float_as_uint(gg0), rr)), g1 = __uint_as_float(__builtin_amdgcn_readlane(__float_as_uint(gg1), rr));
#pragma unroll
                    for (int j = 0; j < 4; ++j) y[j] = (f32x4){bflo(cy0[j].x), bfhi(cy0[j].x), bflo(cy0[j].y), bfhi(cy0[j].y)} * g0 + (f32x4){bflo(cy1[j].x), bfhi(cy1[j].x), bflo(cy1[j].y), bfhi(cy1[j].y)} * g1;
                }
                float ss = 0.f;
#pragma unroll
                for (int j = 0; j < 4; ++j) ss += (y[j].x * y[j].x + y[j].y * y[j].y) + (y[j].z * y[j].z + y[j].w * y[j].w);
                const float rs = 1.0f / sqrtf(wave_sum(ss) * (1.0f / 1024.0f) + EPS);
#pragma unroll
                for (int j = 0; j < 4; ++j) { x[j] += y[j] * rs * a1[j];
                    if (XDST32) *(f32x4*)(A.xdst + (size_t)m * 1024 + 4 * lane + 256 * j) = x[j];
                    else { u32x2 w; w.x = cvtpk(x[j].x, x[j].y); w.y = cvtpk(x[j].z, x[j].w); *(u32x2*)(A.xdst16 + (size_t)m * 1024 + 4 * lane + 256 * j) = w; } }
            }
            if (HAS_NEXT) {
                float ss = 0.f;
#pragma unroll
                for (int j = 0; j < 4; ++j) ss += (x[j].x * x[j].x + x[j].y * x[j].y) + (x[j].z * x[j].z + x[j].w * x[j].w);
                const float rs = 1.0f / sqrtf(wave_sum(ss) * (1.0f / 1024.0f) + EPS);
                f32x4 hv[4];
#pragma unroll
                for (int j = 0; j < 4; ++j) { hv[j] = x[j] * rs * a2[j] + a3[j];
                    u32x2 w; w.x = cvtpk(hv[j].x, hv[j].y); w.y = cvtpk(hv[j].z, hv[j].w); *(u32x2*)(A.Hout + (size_t)m * 1024 + 4 * lane + 256 * j) = w; }
                if (ROUTER) {
                    float lg[8];
#pragma unroll
                    for (int e = 0; e < 8; ++e) { float s = 0.f;
#pragma unroll
                        for (int j = 0; j < 4; ++j) { const f32x4 wv = *(const LAS f32x4*)(Wt + e * 1024 + 4 * lane + 256 * j); s += (hv[j].x * wv.x + hv[j].y * wv.y) + (hv[j].z * wv.z + hv[j].w * wv.w); }
                        lg[e] = wave_sum(s) + brv[e]; }
                    int i1 = 0; float l1 = lg[0];
#pragma unroll
                    for (int e = 1; e < 8; ++e) if (lg[e] > l1) { l1 = lg[e]; i1 = e; }
                    int i2 = -1; float l2 = -__builtin_inff();
#pragma unroll
                    for (int e = 0; e < 8; ++e) if (e != i1 && lg[e] > l2) { l2 = lg[e]; i2 = e; }
                    const float g1 = 1.0f / (1.0f + __expf(l2 - l1)), g2 = 1.0f - g1;
                    if (lane == 0) { A.SEL[m] = i1 | (i2 << 8); A.GATEO[2 * m] = g1; A.GATEO[2 * m + 1] = g2; __hip_atomic_fetch_add(lcnt + i1, 1, __ATOMIC_RELAXED, __HIP_MEMORY_SCOPE_WORKGROUP); __hip_atomic_fetch_add(lcnt + i2, 1, __ATOMIC_RELAXED, __HIP_MEMORY_SCOPE_WORKGROUP); }
                }
            }
        };
        THIN_LOAD(A, 0); THIN_LOAD(B, 1);
        __builtin_amdgcn_sched_barrier(0);
#pragma unroll
        for (int j = 0; j < 4; ++j) {
            if (HAS_Y) a1[j] = q1[j] * q2[j]; else a1[j] = (f32x4){0.f, 0.f, 0.f, 0.f};
            if (HAS_NEXT) { a2[j] = q3[j] * (q4[j] + 1.0f); a3[j] = q5[j]; } else { a2[j] = (f32x4){0.f, 0.f, 0.f, 0.f}; a3[j] = a2[j]; } }
        if constexpr (THIN_DEEP) {
            THIN_LOAD(C, 2); THIN_LOAD(D, 3);
            for (int rr = 0; rr < 16; rr += 4) {
                f32x4 x[4]; u32x2 cy0[4], cy1[4];
                THIN_TAKE(A); THIN_LOAD(A, rr + 4); thin_row(rr, x, cy0, cy1);
                THIN_TAKE(B); THIN_LOAD(B, rr + 5); thin_row(rr + 1, x, cy0, cy1);
                THIN_TAKE(C); THIN_LOAD(C, rr + 6); thin_row(rr + 2, x, cy0, cy1);
                THIN_TAKE(D); THIN_LOAD(D, rr + 7); thin_row(rr + 3, x, cy0, cy1);
            }
        } else {
            for (int rr = 0; rr < 16; rr += 2) {
                f32x4 x[4]; u32x2 cy0[4], cy1[4];
                THIN_TAKE(A); THIN_LOAD(A, rr + 2); thin_row(rr, x, cy0, cy1);
                THIN_TAKE(B); THIN_LOAD(B, rr + 3); thin_row(rr + 1, x, cy0, cy1);
            }
        }
#undef THIN_TAKE
#undef THIN_LOAD
        if (A.router) { __syncthreads(); if (tid < 8) A.CCNT[(gwi >> 3) * 8 + tid] = lcnt[tid]; __syncthreads(); }
    }
}

__device__ __forceinline__ void moe_dispatch_phase(LAS unsigned char* lds, const int* CCNT, const int* SEL, int* SLOT, int* SEGT, int* RIDX, int vcu, int G) {
    const int tid = opaque_tid(), lane = tid & 63, wave = __builtin_amdgcn_readfirstlane(tid >> 6);
    LAS int* PRE = (LAS int*)lds;
    LAS int* TOT = PRE + 2048; LAS int* SEGR = TOT + 8; LAS int* W0C = SEGR + 16;
    {
        const int e = wave; int cv[4]; int s = 0;
#pragma unroll
        for (int i = 0; i < 4; ++i) { cv[i] = CCNT[(4 * lane + i) * 8 + e]; s += cv[i]; }
        int incl = s;
#pragma unroll
        for (int o = 1; o < 64; o <<= 1) { const int t = __shfl_up(incl, o); if (lane >= o) incl += t; }
        int run = incl - s;
#pragma unroll
        for (int i = 0; i < 4; ++i) { PRE[e * 256 + 4 * lane + i] = run; run += cv[i]; }
        if (lane == 63) TOT[e] = incl;
    }
    __syncthreads();
    if (tid == 0) { int r = 0; for (int e = 0; e < 8; ++e) { SEGR[e] = r; r += (TOT[e] + 255) & ~255; } SEGR[8] = r;
        if (blockIdx.x == 0) { for (int e = 0; e <= 8; ++e) SEGT[e] = SEGR[e] >> 8; } }
    __syncthreads();
    for (int e = vcu; e < 8; e += G) { const int p0 = SEGR[e] + TOT[e], p1 = SEGR[e + 1]; for (int u = p0 + tid; u < p1; u += NWAVES * 64) RIDX[u] = 0; }
    for (int chunk = vcu; chunk < 256; chunk += G) {
        const int m0 = chunk * 128;
        int e1 = 0, e2 = 0, r1 = 0, r2 = 0;
        if (wave < 2) {
            const int sel = SEL[m0 + tid]; e1 = sel & 255; e2 = (sel >> 8) & 255;
            const u64 lt = (lane == 0) ? 0ull : (~0ull >> (64 - lane));
#pragma unroll
            for (int e = 0; e < 8; ++e) { const bool f = (e1 == e) || (e2 == e); const u64 bal = __ballot(f); const int rk = __popcll(bal & lt);
                if (e == e1) r1 = rk; if (e == e2) r2 = rk; if (wave == 0 && lane == 0) W0C[e] = __popcll(bal); }
        }
        __syncthreads();
        if (wave < 2) {
            if (wave == 1) { r1 += W0C[e1]; r2 += W0C[e2]; }
            const int s1 = SEGR[e1] + PRE[e1 * 256 + chunk] + r1, s2 = SEGR[e2] + PRE[e2 * 256 + chunk] + r2;
            SLOT[2 * (m0 + tid)] = s1; SLOT[2 * (m0 + tid) + 1] = s2; RIDX[s1] = m0 + tid; RIDX[s2] = m0 + tid;
        }
        __syncthreads();
    }
}

__device__ __forceinline__ void mla_norm_phase(bf16_t* CIN, bf16_t* DST, const float* gq, const float* gkv, const float* cosm, const float* sinm, int vcu, int G) {
    const int tid = opaque_tid(), lane = tid & 63, wave = __builtin_amdgcn_readfirstlane(tid >> 6);
    float g[8];
#pragma unroll
    for (int i = 0; i < 8; ++i) g[i] = lane < 32 ? gq[8 * lane + i] : (lane < 48 ? gkv[8 * (lane & 15) + i] : 0.f);
    const int a8 = 8 * (lane & 3); const bool rl = lane >= 48 && lane < 56, upper = lane >= 52;
    const int stride = G * NWAVES;
    for (int mb = vcu * NWAVES + wave; mb < NTOK; mb += 4 * stride) {
        u32x4 w[4]; f32x4 c0[4], c1[4], s0[4], s1[4];
#pragma unroll
        for (int k = 0; k < 4; ++k) { const int m = mb + k * stride < NTOK ? mb + k * stride : NTOK - 1;
            w[k] = *(const u32x4*)(CIN + (size_t)m * 512 + 8 * lane);
            c0[k] = *(const f32x4*)(cosm + (size_t)m * 32 + a8); c1[k] = *(const f32x4*)(cosm + (size_t)m * 32 + a8 + 4);
            s0[k] = *(const f32x4*)(sinm + (size_t)m * 32 + a8); s1[k] = *(const f32x4*)(sinm + (size_t)m * 32 + a8 + 4); }
#pragma unroll
        for (int k = 0; k < 4; ++k) { const int m = mb + k * stride;
            const float v[8] = {bflo(w[k].x), bfhi(w[k].x), bflo(w[k].y), bfhi(w[k].y), bflo(w[k].z), bfhi(w[k].z), bflo(w[k].w), bfhi(w[k].w)};
            const float cc[8] = {c0[k].x, c0[k].y, c0[k].z, c0[k].w, c1[k].x, c1[k].y, c1[k].z, c1[k].w}, sv[8] = {s0[k].x, s0[k].y, s0[k].z, s0[k].w, s1[k].x, s1[k].y, s1[k].z, s1[k].w};
            float ss = 0.f;
#pragma unroll
            for (int i = 0; i < 8; ++i) ss += v[i] * v[i];
            const float sq = wave_sum(lane < 32 ? ss : 0.f), skv = wave_sum((lane >= 32 && lane < 48) ? ss : 0.f);
            const float rs = lane < 32 ? 1.0f / sqrtf(sq * (1.0f / 256.0f) + EPS) : 1.0f / sqrtf(skv * (1.0f / 128.0f) + EPS);
            float o[8];
#pragma unroll
            for (int i = 0; i < 8; ++i) { const float pv = __shfl_xor(v[i], 4);
                const float r = upper ? (v[i] * cc[i] + pv * sv[i]) : (v[i] * cc[i] - pv * sv[i]);
                o[i] = lane < 48 ? v[i] * rs * g[i] : (rl ? r : 0.f); }
            u32x4 ow; ow.x = cvtpk(o[0], o[1]); ow.y = cvtpk(o[2], o[3]); ow.z = cvtpk(o[4], o[5]); ow.w = cvtpk(o[6], o[7]);
            if (m < NTOK) *(u32x4*)(DST + (size_t)m * 512 + 8 * lane) = ow; }
    }
}

__device__ __forceinline__ void dsa_rope_phase(bf16_t* QKVI, bf16_t* DSTB, bf16_t* KI, const float* gk, const float* cosa, const float* sina, const float* cosi, const float* sini, int vcu, int G) {
    const int tid = opaque_tid(), lane = tid & 63, wave = __builtin_amdgcn_readfirstlane(tid >> 6);
    const float gkl = gk[lane];
    const int stride = G * NWAVES;
    const int kl = lane & 31;
    for (int mb = vcu * NWAVES + wave; mb < NTOK; mb += 4 * stride) {
        float ca[4], sa[4], ci[4], si[4]; bf16_t qa0[4][2], qa1[4][2], ka0[4], ka1[4], ia0[4], ia1[4], kx[4];
#pragma unroll
        for (int k = 0; k < 4; ++k) { const int m = mb + k * stride < NTOK ? mb + k * stride : NTOK - 1; const bf16_t* P = QKVI + (size_t)m * DSAW;
            ca[k] = cosa[(size_t)m * 16 + (lane & 15)]; sa[k] = sina[(size_t)m * 16 + (lane & 15)]; ci[k] = cosi[(size_t)m * 8 + (lane & 7)]; si[k] = sini[(size_t)m * 8 + (lane & 7)];
#pragma unroll
            for (int t = 0; t < 2; ++t) { const int p_ = lane + 64 * t, hd = p_ >> 4, j = p_ & 15; qa0[k][t] = P[hd * 128 + j]; qa1[k][t] = P[hd * 128 + j + 16]; }
            { const int hd = kl >> 4, j = kl & 15; ka0[k] = P[1024 + hd * 128 + j]; ka1[k] = P[1024 + hd * 128 + j + 16]; }
            { const int hd = lane >> 3, j = lane & 7; ia0[k] = P[1536 + hd * 64 + j]; ia1[k] = P[1536 + hd * 64 + j + 8]; }
            kx[k] = P[2048 + lane]; }
#pragma unroll
        for (int k = 0; k < 4; ++k) { const int m = mb + k * stride; if (m >= NTOK) continue;
            bf16_t* Pd = DSTB + (size_t)m * DSAW;
#pragma unroll
            for (int t = 0; t < 2; ++t) { const int p_ = lane + 64 * t, hd = p_ >> 4, j = p_ & 15; bf16_t* d = Pd + hd * 128 + j;
                const float x1 = bf2f(qa0[k][t]), x2 = bf2f(qa1[k][t]); const unsigned w = cvtpk(x1 * ca[k] - x2 * sa[k], x2 * ca[k] + x1 * sa[k]); d[0] = (bf16_t)(w & 0xffff); d[16] = (bf16_t)(w >> 16); }
            if (lane < 32) { const int hd = lane >> 4, j = lane & 15; bf16_t* d = Pd + 1024 + hd * 128 + j;
                const float x1 = bf2f(ka0[k]), x2 = bf2f(ka1[k]); const unsigned w = cvtpk(x1 * ca[k] - x2 * sa[k], x2 * ca[k] + x1 * sa[k]); d[0] = (bf16_t)(w & 0xffff); d[16] = (bf16_t)(w >> 16); }
            { const int hd = lane >> 3, j = lane & 7; bf16_t* d = Pd + 1536 + hd * 64 + j;
                const float x1 = bf2f(ia0[k]), x2 = bf2f(ia1[k]); const unsigned w = cvtpk(x1 * ci[k] - x2 * si[k], x2 * ci[k] + x1 * si[k]); d[0] = (bf16_t)(w & 0xffff); d[8] = (bf16_t)(w >> 16); }
            { const float x = bf2f(kx[k]); const float ss = wave_sum(x * x);
                const float y = x * (1.0f / sqrtf(ss * (1.0f / 64.0f) + EPS)) * gkl;
                const float yp = __shfl_xor(y, 8);
                float o = y;
                if (lane < 8) o = y * ci[k] - yp * si[k]; else if (lane < 16) o = y * ci[k] + yp * si[k];
                const unsigned w = cvtpk(o, 0.f); Pd[2048 + lane] = (bf16_t)(w & 0xffff); KI[(size_t)m * 64 + lane] = (bf16_t)(w & 0xffff); }
        }
    }
}

constexpr int D3_H_OFF = RING_BYTES + 512, D3_HQ = 320;
static_assert(D3_H_OFF + 8 * D3_HQ * 4 <= LDS_BYTES, "select histograms");
__device__ __forceinline__ void wlane2(unsigned lo, unsigned hi, int ln, unsigned& vlo, unsigned& vhi) {
    ln = __builtin_amdgcn_readfirstlane(ln); lo = __builtin_amdgcn_readfirstlane(lo); hi = __builtin_amdgcn_readfirstlane(hi); unsigned keep;
    asm volatile("s_mov_b32 %2, m0\n\ts_mov_b32 m0, %5\n\ts_nop 3\n\tv_writelane_b32 %0, %3, m0\n\tv_writelane_b32 %1, %4, m0\n\ts_mov_b32 m0, %2" : "+v"(vlo), "+v"(vhi), "=&s"(keep) : "s"(lo), "s"(hi), "s"(ln));
}
__device__ __forceinline__ unsigned ord16(float f) { const _Float16 hf = (_Float16)(f + 0.0f); const unsigned b = (unsigned)__builtin_bit_cast(unsigned short, hf);
    const unsigned sgn = (unsigned)((int)(b << 16) >> 31);    return (b ^ (sgn | 0x8000u)) & 0xFFFFu; }
__device__ __forceinline__ void find_bin(const LAS unsigned* Hq, int lane, int target, int& bin, int& above, int& cnt) {
    const u32x4 c = *(const LAS u32x4*)(Hq + 4 * lane);
    const int ls = (int)(c.x + c.y + c.z + c.w); int S = ls;
#pragma unroll
    for (int o = 1; o < 64; o <<= 1) { const int v = __shfl_down(S, o); if (lane + o < 64) S += v; }
    const u64 m = __ballot(S >= target);
    const int L = m ? 63 - __builtin_clzll(m) : 0;
    const int ab = __builtin_amdgcn_readlane(S - ls, L);
    const int d0 = __builtin_amdgcn_readlane((int)c.x, L), d1 = __builtin_amdgcn_readlane((int)c.y, L), d2 = __builtin_amdgcn_readlane((int)c.z, L), d3 = __builtin_amdgcn_readlane((int)c.w, L);
    int cum = ab;
    if (cum + d3 >= target) { bin = 4 * L + 3; above = cum; cnt = d3; }
    else { cum += d3; if (cum + d2 >= target) { bin = 4 * L + 2; above = cum; cnt = d2; }
        else { cum += d2; if (cum + d1 >= target) { bin = 4 * L + 1; above = cum; cnt = d1; } else { cum += d1; bin = 4 * L; above = cum; cnt = d0; } } }
}
__device__ __forceinline__ void dsa_select_phase(LAS unsigned char* lds, const bf16_t* QKVI, const bf16_t* KI, u64* MASK, int vcu, int G) {
    const int tid = opaque_tid(), lane = tid & 63, wave = __builtin_amdgcn_readfirstlane(tid >> 6);
    LAS unsigned short* SC = (LAS unsigned short*)lds;
    LAS unsigned* HB = (LAS unsigned*)(lds + D3_H_OFF);
    const int r32 = lane & 31, hi = lane >> 5;
    constexpr int NU = NTOK / 8;
    for (int rnd = 0; rnd * G < NU; ++rnd) {
        int b, grp;
        if (G == 256) { const int x = vcu >> 5, w = ((x >> 2) << 5) | (vcu & 31); if (rnd >= 16) break; b = x & 3; grp = 1023 - (rnd * 64 + ((rnd & 1) ? 63 - w : w)); }
        else { const int k = rnd * G + ((rnd & 1) ? (G - 1 - vcu) : vcu); if (k >= NU) continue; b = k & 3; grp = 1023 - (k >> 2); }
        const int t0 = grp * 8; const size_t tok0 = (size_t)b * SEQ;
        const int t = t0 + wave;
        if (t0 < 256) {
            if (lane < 4) { const int d = t - 64 * lane; const u64 w = d < 0 ? 0ull : (d >= 63 ? ~0ull : ((1ull << (d + 1)) - 1ull)); MASK[((size_t)b * 128 + lane) * SEQ + t] = w; }
            continue;
        }
        for (int rep1_ = 0; rep1_ < (((DUP_MASK) & 1024) ? 2 : 1); ++rep1_) {
        if (rep1_) __syncthreads();
        for (int u = tid; u < 8 * D3_HQ; u += 512) HB[u] = 0u;
        __syncthreads();
        {
            bf16x8 qa[2][4]; bf16x8 wq[2][2];
#pragma unroll
            for (int blk = 0; blk < 2; ++blk) { const bf16_t* qp = QKVI + (tok0 + t0 + 4 * blk + (r32 >> 3)) * DSAW + 1536 + (r32 & 7) * 64 + hi * 8;
#pragma unroll
                for (int ks = 0; ks < 4; ++ks) qa[blk][ks] = *(const bf16x8*)(qp + ks * 16); }
            { u32x2 ww = (u32x2){0u, 0u};
              if (r32 < 8) ww = *(const u32x2*)(QKVI + (tok0 + t0 + r32) * DSAW + 2112 + 4 * hi);
#pragma unroll
              for (int blk = 0; blk < 2; ++blk)
#pragma unroll
                  for (int kst = 0; kst < 2; ++kst) { const bool mt = r32 < 8 && (r32 >> 2) == blk && ((r32 & 3) >> 1) == kst; const bool hiq = (r32 & 1) != 0;
                      u32x4 f; f.x = (mt && !hiq) ? ww.x : 0u; f.y = (mt && !hiq) ? ww.y : 0u; f.z = (mt && hiq) ? ww.x : 0u; f.w = (mt && hiq) ? ww.y : 0u;
                      wq[blk][kst] = *reinterpret_cast<bf16x8*>(&f); } }
            const int nk = t0 + 8, ntile = ((nk + 511) & ~511) >> 5, nreal = (nk + 31) >> 5;
            const bf16_t* kbase = KI + tok0 * 64 + hi * 8;
            bf16x8 kb[4], kn[4];
#define D3_LOADK(dst, tl) do { if ((tl) < nreal) { _Pragma("unroll") for (int ks = 0; ks < 4; ++ks) dst[ks] = *(const bf16x8*)(kbase + (size_t)((tl) * 32 + r32) * 64 + ks * 16); } } while (0)
#define D3_TILE(KB, tl, UNC) do { const int tl_ = (tl); const int s = tl_ * 32 + r32;                                                 \
                if ((UNC) || tl_ < nreal) {                                                                                      \
                    f32x16 acc0 = {}, acc1 = {};                                                                                 \
                    _Pragma("unroll") for (int ks = 0; ks < 4; ++ks) { acc0 = __builtin_amdgcn_mfma_f32_32x32x16_bf16(qa[0][ks], KB[ks], acc0, 0, 0, 0); acc1 = __builtin_amdgcn_mfma_f32_32x32x16_bf16(qa[1][ks], KB[ks], acc1, 0, 0, 0); } \
                    if (UNC) { _Pragma("unroll") for (int ks = 0; ks < 4; ++ks) KB[ks] = *(const bf16x8*)(kbase + (size_t)((tl_ + 16) * 32 + r32) * 64 + ks * 16); } else D3_LOADK(KB, tl_ + 16); \
                    f32x16 c2 = {};                                                                                              \
                    _Pragma("unroll") for (int kst = 0; kst < 2; ++kst) {                                                        \
                        u32x4 b0_, b1_;                                                                                          \
                        b0_.x = cvtpk_c(acc0[8 * kst + 0], acc0[8 * kst + 1]); b0_.y = cvtpk_c(acc0[8 * kst + 2], acc0[8 * kst + 3]); b0_.z = cvtpk_c(acc0[8 * kst + 4], acc0[8 * kst + 5]); b0_.w = cvtpk_c(acc0[8 * kst + 6], acc0[8 * kst + 7]); \
                        b1_.x = cvtpk_c(acc1[8 * kst + 0], acc1[8 * kst + 1]); b1_.y = cvtpk_c(acc1[8 * kst + 2], acc1[8 * kst + 3]); b1_.z = cvtpk_c(acc1[8 * kst + 4], acc1[8 * kst + 5]); b1_.w = cvtpk_c(acc1[8 * kst + 6], acc1[8 * kst + 7]); \
                        const bf16x8 r0_ = __builtin_elementwise_max(*reinterpret_cast<bf16x8*>(&b0_), (bf16x8)0), r1_ = __builtin_elementwise_max(*reinterpret_cast<bf16x8*>(&b1_), (bf16x8)0);     \
                        c2 = __builtin_amdgcn_mfma_f32_32x32x16_bf16(wq[0][kst], r0_, c2, 0, 0, 0); c2 = __builtin_amdgcn_mfma_f32_32x32x16_bf16(wq[1][kst], r1_, c2, 0, 0, 0); } \
                    const bool diag = !(UNC) && tl_ * 32 + 31 > t0;     \
                    _Pragma("unroll") for (int i = 0; i < 4; ++i) { const int q = 4 * hi + i; unsigned key = ord16(c2[i]);       \
                        if (diag && s > t0 + q) key = 0u;                                                                        \
                        SC[q * 8192 + s] = (unsigned short)key;                                                                  \
                        if ((UNC) || key) __hip_atomic_fetch_add(HB + q * D3_HQ + (key >> 8), 1u, __ATOMIC_RELAXED, __HIP_MEMORY_SCOPE_WORKGROUP); } \
                } else {                                                                                                         \
                    _Pragma("unroll") for (int i = 0; i < 4; ++i) SC[(4 * hi + i) * 8192 + s] = 0;                            \
                } } while (0)
            int tile = wave;
            D3_LOADK(kb, tile); D3_LOADK(kn, tile + 8);
            for (; tile + 24 < nreal; tile += 16) {
                D3_TILE(kb, tile, true);
                D3_TILE(kn, tile + 8, true);
            }
            for (; tile < ntile; tile += 16) {
                D3_TILE(kb, tile, false);
                if (tile + 8 < ntile) D3_TILE(kn, tile + 8, false);
            }
#undef D3_TILE
#undef D3_LOADK
        }
        }
        __syncthreads();
        {
            LAS unsigned* Hq = HB + wave * D3_HQ;
            int b1, ab1, c1; find_bin(Hq, lane, 256, b1, ab1, c1);
            const int k2 = 256 - ab1;
#pragma unroll
            for (int i = 0; i < 5; ++i) Hq[lane + 64 * i] = 0u;
            const int nch = (t + 512) >> 9;
            for (int i = 0; i < nch; ++i) {
                const u32x4 kx = *(const LAS u32x4*)(SC + wave * 8192 + (i * 64 + lane) * 8);
#pragma unroll
                for (int w = 0; w < 4; ++w) { const unsigned x = kx[w];
                    const unsigned lo = x & 0xffffu, hh = x >> 16;
                    const unsigned binl = ((lo >> 8) == (unsigned)b1) ? (lo & 255u) : (256u + lane), binh = ((hh >> 8) == (unsigned)b1) ? (hh & 255u) : (256u + lane);
                    __hip_atomic_fetch_add(Hq + binl, 1u, __ATOMIC_RELAXED, __HIP_MEMORY_SCOPE_WORKGROUP); __hip_atomic_fetch_add(Hq + binh, 1u, __ATOMIC_RELAXED, __HIP_MEMORY_SCOPE_WORKGROUP); }
            }
            int b2, ab2, c2; find_bin(Hq, lane, k2, b2, ab2, c2);
            const unsigned tau = ((unsigned)b1 << 8) | (unsigned)b2;
            int need = k2 - ab2;
            const bool ties = need != c2;
            const int jmax = (t | 255) >> 6;
            unsigned w0l = 0u, w0h = 0u, w1l = 0u, w1h = 0u;
            const LAS unsigned short* Sq = SC + wave * 8192 + lane;
            if (!ties) {
                for (int j = 0; j <= jmax; j += 4) {
                    unsigned key[4];
#pragma unroll
                    for (int u = 0; u < 4; ++u) key[u] = Sq[(j + u) * 64];
                    if (j < 64) {
#pragma unroll
                        for (int u = 0; u < 4; ++u) { const u64 wd = __ballot(key[u] >= tau); wlane2((unsigned)wd, (unsigned)(wd >> 32), j + u, w0l, w0h); } }
                    else {
#pragma unroll
                        for (int u = 0; u < 4; ++u) { const u64 wd = __ballot(key[u] >= tau); wlane2((unsigned)wd, (unsigned)(wd >> 32), j + u - 64, w1l, w1h); } }
                }
            } else {
                for (int j = 0; j <= jmax; ++j) {
                    const unsigned key = Sq[j * 64];
                    const u64 bg = __ballot(key > tau), be = __ballot(key == tau);
                    u64 sel = be; const int pe = __popcll(be);
                    if (pe > need) { u64 rem = be; sel = 0ull; for (int q = 0; q < need; ++q) { const u64 low = rem & (0ull - rem); sel |= low; rem ^= low; } }
                    need -= __popcll(sel);
                    const u64 wd = bg | sel;
                    if (j < 64) { wlane2((unsigned)wd, (unsigned)(wd >> 32), j, w0l, w0h); }
                    else { wlane2((unsigned)wd, (unsigned)(wd >> 32), j - 64, w1l, w1h); }
                }
            }
            if (lane <= jmax) MASK[((size_t)b * 128 + lane) * SEQ + t] = ((u64)w0h << 32) | w0l;
            if (64 + lane <= jmax) MASK[((size_t)b * 128 + 64 + lane) * SEQ + t] = ((u64)w1h << 32) | w1l;
        }
        LDS_BARRIER();
    }
}
#ifndef MK_SPLIT
#define MK_SPLIT 0
#endif
#ifndef DUP_MASK
#define DUP_MASK 0
#endif
#define THIN_RUN(A, ...) do { if ((DUP_MASK) & 128) { ThinArgs D_ = (A); if (D_.xdst) D_.xdst = (float*)P_BIG; if (D_.xdst16) D_.xdst16 = P_BIG; D_.Hout = P_BIG + 64 * 1024 * 1024; thin_phase<__VA_ARGS__>(lds, D_, vcu, G); } thin_phase<__VA_ARGS__>(lds, (A), vcu, G); } while (0)
#define REP(bit) for (int rep_ = 0; rep_ < (((DUP_MASK) & (bit)) ? 2 : 1); ++rep_)
constexpr int CW_BAR = 4096;
constexpr int MAX_BAR_REGIONS = 48;
constexpr int CW_AFLAG = 64;
#ifndef FORCE_FALLBACK
#define FORCE_FALLBACK 0
#endif
static_assert((CW_BAR + MAX_BAR_REGIONS * XCD_BAR_WORDS) * 4 <= (int)CTL_ZERO_BYTES && (CW_BAR + XCD_BAR_WORDS) * 4 <= 32768, "barrier regions inside the memset");

struct Args { const float* in[23]; float* out; unsigned char* ws; int ph_lo, ph_hi, li, pad; };

__global__ void __launch_bounds__(NWAVES * 64, 2) trunk_fwd(Args args) {
    extern __shared__ __attribute__((aligned(16))) unsigned char lds_raw[];
    LAS unsigned char* lds = (LAS unsigned char*)lds_raw;
    volatile LAS unsigned* MISC = (volatile LAS unsigned*)(lds + MISC_OFF);
    const int tid = threadIdx.x, lane = tid & 63, wave = __builtin_amdgcn_readfirstlane(tid >> 6);
    const int G = gridDim.x; const int bx = blockIdx.x; const int vcu = (G % 8 == 0) ? (bx % 8) * (G / 8) + bx / 8 : bx;
    unsigned* ctl = (unsigned*)(args.ws + WS_CTL);
    for (int u = tid; u < (LDS_BYTES - LDSCTL_OFF) / 4; u += NWAVES * 64) ((LAS unsigned*)(lds + LDSCTL_OFF))[u] = 0u;
    __syncthreads();
    const int lo = args.ph_lo, hi = args.ph_hi;
    XcdBarrier bar; bar.bar = ctl + CW_BAR + args.li * XCD_BAR_WORDS; bar.x = 0; bar.st = nullptr;
    if (hi - lo > 1) bar = xcd_barrier_post(ctl + CW_BAR + args.li * XCD_BAR_WORDS, MISC + 8);
    int ph = 0; const int li_ = args.li;
#define IN_PH() (lo <= ph && ph < hi)
#define SEAM() do { if (IN_PH() && ph + 1 < hi) { XcdBarrier b_ = bar; { unsigned* bp_ = bar.bar; asm volatile("" : "+s"(bp_)); b_.bar = bp_; } xcd_barrier(b_); if ((DUP_MASK) & 512) xcd_barrier(b_); } ++ph; } while (0)

#define WSP (args.ws)
#define INP(i) (args.in[i])
#define P_ws WSP
#define P_out (args.out)
#define P_MOD ((float*)(WSP + WS_MOD))
#define P_H ((bf16_t*)(args.out))
#define P_X16 ((bf16_t*)(WSP + WS_H))
#define P_BIG ((bf16_t*)(WSP + WS_BIG))
#define P_BIG2 ((bf16_t*)(WSP + WS_BIG2))
#define P_O ((bf16_t*)(WSP + WS_O))
#define P_CIN ((bf16_t*)(WSP + BIG_MLA_CIN))
#define P_MASK ((u64*)(WSP + BIG_DSA_MASK))
#define P_KIX ((bf16_t*)(WSP + BIG_DSA_MASK + 32 * MiB))
#define P_SEL ((int*)(WSP + MOE_SEL))
#define P_GATE ((float*)(WSP + MOE_GATE))
#define P_SLOT ((int*)(WSP + MOE_SLOT))
#define P_CCNT ((int*)(WSP + MOE_CCNT))
#define P_SEGT ((int*)(WSP + MOE_SEG))
#define P_RIDX ((int*)(WSP + MOE_RIDX))
#define P_normg INP(5)

    if (IN_PH()) REP(64) prologue_phase(lds, args.in, (const int*)args.in[2], args.ws, vcu, G);
    SEAM();
    if (IN_PH()) { ThinArgs A{}; A.xsrc = INP(0); A.H = P_H; A.has_y = 0; A.ymode = 0; A.has_next = 1; A.router = 0;
        A.nsc = P_MOD + 1024; A.nsh = P_MOD; A.gpre = P_normg; A.Hout = P_H; THIN_RUN(A, true, false, 0, true, false, false); }
    SEAM();

    for (int layer = 0; layer < DEPTH; ++layer) {
        const int kind = layer % 3, f = layer >> 1; const bool moe = (layer & 1) != 0;
        const float* MODl = P_MOD + (size_t)layer * 4 * 6144;
        if (IN_PH()) REP(1) {
            const bf16_t* Bt = kind == 0 ? (const bf16_t*)(P_ws + W_SBIN) + (size_t)(layer == 3 ? 1 : 0) * SBW * DM : (kind == 1 ? (const bf16_t*)(P_ws + W_MLAIN) : (const bf16_t*)(P_ws + W_DSAIN));
            const int N = kind == 0 ? SBW : (kind == 1 ? MLAW : DSAW);
            bf16_t* outp = kind == 1 ? P_CIN : P_BIG;
            pg8::Gemm g{P_H, Bt, DM, DM}; pg8::StaticOrder S; S.init(NTOK, N, G, bx); pg8::EpiStore E{outp, N};
            pg8::gemm_phase<pg8::EpiStore, pg8::StaticOrder, true>(lds + RING_OFF, g, S, E);
        }
        SEAM();
        if (kind == 1) {
            if (IN_PH()) { if ((DUP_MASK) & 256) mla_norm_phase(P_CIN, P_BIG2, INP(9), INP(11), (const float*)(P_ws + RP_COSM), (const float*)(P_ws + RP_SINM), vcu, G);
                mla_norm_phase(P_CIN, P_CIN, INP(9), INP(11), (const float*)(P_ws + RP_COSM), (const float*)(P_ws + RP_SINM), vcu, G); }
            SEAM();
            if (IN_PH()) REP(1) {
                { pg8::Gemm g{P_CIN, (const bf16_t*)(P_ws + W_MLAQ), MLAW, 256}; pg8::StaticOrder S; S.init(NTOK, 1536, G, bx); pg8::EpiStore E{P_BIG, 1536};
                  pg8::gemm_phase<pg8::EpiStore, pg8::StaticOrder, true>(lds + RING_OFF, g, S, E); }
                { int kkv = 128; asm volatile("" : "+s"(kkv));
                  pg8::Gemm g{P_CIN + 256, (const bf16_t*)(P_ws + W_MLAKV), MLAW, kkv}; pg8::StaticOrder S; S.init(NTOK, 2048, G, bx); pg8::EpiStore E{P_BIG2, 2048};
                  pg8::gemm_phase<pg8::EpiStore, pg8::StaticOrder, true>(lds + RING_OFF, g, S, E); }
            }
            SEAM();
        }
        if (kind == 2) {
            if (IN_PH()) { if ((DUP_MASK) & 256) dsa_rope_phase(P_BIG, P_BIG2, P_KIX, INP(15), (const float*)(P_ws + RP_COSA), (const float*)(P_ws + RP_SINA), (const float*)(P_ws + RP_COSI), (const float*)(P_ws + RP_SINI), vcu, G);
                dsa_rope_phase(P_BIG, P_BIG, P_KIX, INP(15), (const float*)(P_ws + RP_COSA), (const float*)(P_ws + RP_SINA), (const float*)(P_ws + RP_COSI), (const float*)(P_ws + RP_SINI), vcu, G); }
            SEAM();
            if (IN_PH()) REP(32) dsa_select_phase(lds, P_BIG, P_KIX, P_MASK, vcu, G);
            SEAM();
        }
        if (IN_PH()) {
            fa::AttnArgs A{};
            A.O = P_O;
            if (kind == 0) { A.Q = P_BIG; A.qpitch = SBW; A.qhs = 128; A.K = P_BIG + 1024; A.kpitch = SBW; A.khs = 128; A.V = P_BIG + 2048; A.vpitch = SBW; A.vhs = 128; A.kvdiv = 1;
                REP(4) fa::attn_phase<0>(lds, A, vcu, G); }
            else if (kind == 1) { A.Q = P_BIG; A.qpitch = 1536; A.qhs = 192; A.K = P_BIG2; A.kpitch = 2048; A.khs = 256; A.V = P_BIG2 + 128; A.vpitch = 2048; A.vhs = 256; A.kvdiv = 1;
                A.KR = P_CIN + 384; A.krpitch = MLAW; A.cosm = (const float*)(P_ws + RP_COSM); A.sinm = (const float*)(P_ws + RP_SINM);
                A.flag = ctl + CW_AFLAG + layer; REP(8) fa::attn_phase<1, true>(lds, A, vcu, G); }
            else { A.Q = P_BIG; A.qpitch = DSAW; A.qhs = 128; A.K = P_BIG + 1024; A.kpitch = DSAW; A.khs = 128; A.V = P_BIG + 1280; A.vpitch = DSAW; A.vhs = 128; A.kvdiv = 4; A.mask = P_MASK;
                A.flag = ctl + CW_AFLAG + layer; REP(16) fa::attn_phase<2, true>(lds, A, vcu, G); }
        }
        SEAM();
        if (IN_PH() && kind != 0) {
            if ((FORCE_FALLBACK) || __hip_atomic_load(ctl + CW_AFLAG + layer, __ATOMIC_RELAXED, __HIP_MEMORY_SCOPE_AGENT) != 0u) {
                if (kind == 1) { fa::AttnArgs A{}; A.O = P_O; A.Q = P_BIG; A.qpitch = 1536; A.qhs = 192; A.K = P_BIG2; A.kpitch = 2048; A.khs = 256; A.V = P_BIG2 + 128; A.vpitch = 2048; A.vhs = 256; A.kvdiv = 1;
                    A.KR = P_CIN + 384; A.krpitch = MLAW; A.cosm = (const float*)(P_ws + RP_COSM); A.sinm = (const float*)(P_ws + RP_SINM);
                    fa::attn_phase<1, false>(lds, A, vcu, G); }
                else { fa::AttnArgs A{}; A.O = P_O; A.Q = P_BIG; A.qpitch = DSAW; A.qhs = 128; A.K = P_BIG + 1024; A.kpitch = DSAW; A.khs = 128; A.V = P_BIG + 1280; A.vpitch = DSAW; A.vhs = 128; A.kvdiv = 4; A.mask = P_MASK;
                    fa::attn_phase<2, false>(lds, A, vcu, G); }
                { XcdBarrier b_ = bar; { unsigned* bp_ = bar.bar; asm volatile("" : "+s"(bp_)); b_.bar = bp_; } xcd_barrier(b_); } } }
        if (IN_PH()) REP(1) {
            const bf16_t* Bt = kind == 0 ? (const bf16_t*)(P_ws + W_SBOUT) + (size_t)(layer == 3 ? 1 : 0) * DM * DM : (kind == 1 ? (const bf16_t*)(P_ws + W_MLAOUT) : (const bf16_t*)(P_ws + W_DSAOUT));
            pg8::Gemm g{P_O, Bt, DM, DM}; pg8::StaticOrder S; S.init(NTOK, DM, G, bx); pg8::EpiStore E{P_H, DM};
            pg8::gemm_phase<pg8::EpiStore, pg8::StaticOrder, true>(lds + RING_OFF, g, S, E);
        }
        SEAM();
        if (IN_PH()) { ThinArgs A{}; if (layer == 0) A.xsrc = INP(0); else A.xsrc16 = P_X16; A.xdst16 = P_X16; A.H = P_H; A.has_y = 1; A.ymode = 0; A.has_next = 1; A.router = moe ? 1 : 0;
            A.gate = MODl + 2048; A.gpost = P_normg + (layer * 4 + 1) * 1024; A.nsc = MODl + 4096; A.nsh = MODl + 3072; A.gpre = P_normg + (layer * 4 + 2) * 1024;
            A.wr = INP(19) + (size_t)f * 8192; A.br = INP(20) + f * 8; A.SEL = P_SEL; A.GATEO = P_GATE; A.CCNT = P_CCNT;
            A.Hout = P_H;
            if (layer == 0) THIN_RUN(A, true, true, 0, true, false, false); else if (moe) THIN_RUN(A, false, true, 0, true, true, false); else THIN_RUN(A, false, true, 0, true, false, false); }
        SEAM();
        if (moe) {
            if (IN_PH()) REP(256) moe_dispatch_phase(lds, P_CCNT, P_SEL, P_SLOT, P_SEGT, P_RIDX, vcu, G);
            SEAM();
        }
        if (IN_PH()) REP(2) {
            pg8::GroupOrder S; S.G = G; S.c = bx;
            if (moe) { S.nN = 11;
#pragma unroll
                for (int e = 0; e < 9; ++e) S.st[e] = P_SEGT[e];
                S.nM = S.st[8];
                pg8::Gemm g{P_H, (const bf16_t*)(P_ws + W_MOEGU) + (size_t)f * NEXP * 2 * DFFE * DM, DM, DM}; pg8::EpiSwiGLU E{P_BIG, DFFE};
                pg8::gemm_phase<pg8::EpiSwiGLU, pg8::GroupOrder, true, true>(lds + RING_OFF, g, S, E, P_RIDX); }
            else { S.nN = 22; S.nM = NTOK / 256; S.st[0] = 0;
#pragma unroll
                for (int e = 1; e < 9; ++e) S.st[e] = NTOK / 256;
                pg8::Gemm g{P_H, (const bf16_t*)(P_ws + W_FFNGU) + (size_t)f * 2 * DFF * DM, DM, DM}; pg8::EpiSwiGLU E{P_BIG, DFF};
                pg8::gemm_phase<pg8::EpiSwiGLU, pg8::GroupOrder, true>(lds + RING_OFF, g, S, E); }
        }
        SEAM();
        if (IN_PH()) REP(2) {
            pg8::GroupOrder S; S.G = G; S.c = bx; S.nN = 4;
            if (moe) {
#pragma unroll
                for (int e = 0; e < 9; ++e) S.st[e] = P_SEGT[e];
                S.nM = S.st[8];
                pg8::Gemm g{P_BIG, (const bf16_t*)(P_ws + W_MOEDN) + (size_t)f * NEXP * DM * DFFE, DFFE, DFFE}; pg8::EpiStore E{P_BIG2, DM};
                pg8::gemm_phase<pg8::EpiStore, pg8::GroupOrder, true>(lds + RING_OFF, g, S, E); }
            else { S.nM = NTOK / 256; S.st[0] = 0;
#pragma unroll
                for (int e = 1; e < 9; ++e) S.st[e] = NTOK / 256;
                pg8::Gemm g{P_BIG, (const bf16_t*)(P_ws + W_FFNDN) + (size_t)f * DM * DFF, DFF, DFF}; pg8::EpiStore E{P_H, DM};
                pg8::gemm_phase<pg8::EpiStore, pg8::GroupOrder, true>(lds + RING_OFF, g, S, E); }
        }
        SEAM();
        if (IN_PH()) { ThinArgs A{}; A.xsrc16 = P_X16; if (layer == DEPTH - 1) A.xdst = P_out; else A.xdst16 = P_X16; A.H = P_H; A.has_y = 1; A.ymode = moe ? 1 : 0; A.has_next = layer < DEPTH - 1 ? 1 : 0; A.router = 0;
            A.gate = MODl + 5120; A.gpost = P_normg + (layer * 4 + 3) * 1024;
            if (layer < DEPTH - 1) { const float* MODn = MODl + 4 * 6144; A.nsc = MODn + 1024; A.nsh = MODn; A.gpre = P_normg + ((layer + 1) * 4) * 1024; }
            A.OUTR = P_BIG2; A.SLOT = P_SLOT; A.GATEV = P_GATE; A.Hout = P_H;
            if (!moe) THIN_RUN(A, false, true, 0, true, false, false); else if (layer < DEPTH - 1) THIN_RUN(A, false, true, 1, true, false, false); else THIN_RUN(A, false, true, 1, false, false, true); }
        SEAM();
    }
#undef IN_PH
#undef SEAM
#undef P_ws
#undef WSP
#undef INP
#undef P_out
#undef P_MOD
#undef P_H
#undef P_X16
#undef P_BIG
#undef P_BIG2
#undef P_O
#undef P_CIN
#undef P_MASK
#undef P_KIX
#undef P_SEL
#undef P_GATE
#undef P_SLOT
#undef P_CCNT
#undef P_SEGT
#undef P_RIDX
#undef P_normg
}

constexpr int N_PHASES = 2 + 7 + 10 + 9 + 8;
extern "C" void kernel_launch(void* const* d_in, const int* in_sizes, int n_in, void* d_out, int out_size, void* d_ws, size_t ws_size, hipStream_t stream) {
    static int grid = 0;
    if (grid == 0) {
        if (n_in != 23 || in_sizes[0] != NTOK * DM || out_size != NTOK * DM || ws_size < WS_END) { fprintf(stderr, "kernel_launch: unexpected shapes / workspace (n_in %d, ws %zu, need %zu)\n", n_in, ws_size, (size_t)WS_END); grid = -1; return; }
        int dev = 0, cus = 0, per_cu = 0;
        if (hipGetDevice(&dev) != hipSuccess || hipDeviceGetAttribute(&cus, hipDeviceAttributeMultiprocessorCount, dev) != hipSuccess) { grid = -1; return; }
        if (hipFuncSetAttribute((const void*)trunk_fwd, hipFuncAttributeMaxDynamicSharedMemorySize, LDS_BYTES) != hipSuccess) { grid = -1; return; }
        if (hipOccupancyMaxActiveBlocksPerMultiprocessor(&per_cu, (const void*)trunk_fwd, NWAVES * 64, LDS_BYTES) != hipSuccess || per_cu < 1) { (void)hipGetLastError(); fprintf(stderr, "kernel_launch: occupancy query reports %d\n", per_cu); }
        (void)hipGetLastError();
        grid = cus;
    }
    if (grid < 0) return;
    if (hipMemsetAsync((char*)d_ws + WS_CTL, 0, (MK_SPLIT == 0) ? (size_t)32768 : CTL_ZERO_BYTES, stream) != hipSuccess) return;
    Args a{};
    for (int i = 0; i < 23; ++i) a.in[i] = (const float*)d_in[i];
    a.out = (float*)d_out; a.ws = (unsigned char*)d_ws; a.pad = 0;
#if MK_SPLIT == 0
    a.ph_lo = 0; a.ph_hi = N_PHASES; a.li = 0;
    hipLaunchKernelGGL(trunk_fwd, dim3(grid), dim3(NWAVES * 64), LDS_BYTES, stream, a);
#else
    int li = 0;
    for (int p = 0; p < N_PHASES; p += MK_SPLIT, ++li) {
        a.ph_lo = p; a.ph_hi = (p + MK_SPLIT < N_PHASES) ? p + MK_SPLIT : N_PHASES; a.li = li;
        hipLaunchKernelGGL(trunk_fwd, dim3(grid), dim3(NWAVES * 64), LDS_BYTES, stream, a);
    }
#endif
}
```

```cpp
#include <hip/hip_runtime.h>
#include <cstdio>
#include <cstdint>

#ifndef DUP_MASK
#define DUP_MASK 0
#endif
#define GAS __attribute__((address_space(1)))
#define LAS __attribute__((address_space(3)))
typedef unsigned short bf16_t;
typedef short bf16x8 __attribute__((ext_vector_type(8)));
typedef short s16x4 __attribute__((ext_vector_type(4)));
typedef float f32x2 __attribute__((ext_vector_type(2)));
typedef float f32x4 __attribute__((ext_vector_type(4)));
typedef float f32x16 __attribute__((ext_vector_type(16)));
typedef unsigned u32x2 __attribute__((ext_vector_type(2)));
typedef unsigned u32x4 __attribute__((ext_vector_type(4)));
typedef unsigned long long u64;

constexpr int DM = 1024, NB = 4, SEQ = 8192, NTOK = NB * SEQ, DEPTH = 4;
constexpr int DFF = 2816, NEXP = 8, DFFE = 1408;
constexpr int SBW = 3072, MLAW = 512, DSAW = 2304, DSAW_REAL = 2120, MLAW_REAL = 448;
constexpr int NSLOT = 2 * NTOK + NEXP * 256;
constexpr float EPS = 1e-6f;

constexpr size_t MiB = 1u << 20;
constexpr size_t WS_CTL = 0, CTL_ZERO_BYTES = 1 * MiB;
constexpr size_t WS_MOD = 1 * MiB;
constexpr size_t WS_MOE = 2 * MiB;
constexpr size_t MOE_SEL = WS_MOE, MOE_GATE = MOE_SEL + (size_t)NTOK * 4, MOE_SLOT = MOE_GATE + (size_t)NTOK * 8, MOE_CCNT = MOE_SLOT + (size_t)NTOK * 8, MOE_SEG = MOE_CCNT + 256 * 8 * 4, MOE_RIDX = MOE_SEG + 256;
static_assert(MOE_RIDX + (size_t)NSLOT * 4 <= 3 * MiB, "moe tables");
constexpr size_t WS_ROPE = 3 * MiB;
constexpr size_t RP_COSM = WS_ROPE, RP_SINM = RP_COSM + (size_t)NTOK * 32 * 4, RP_COSA = RP_SINM + (size_t)NTOK * 32 * 4, RP_SINA = RP_COSA + (size_t)NTOK * 16 * 4,
                 RP_COSI = RP_SINA + (size_t)NTOK * 16 * 4, RP_SINI = RP_COSI + (size_t)NTOK * 8 * 4;
static_assert(RP_SINI + (size_t)NTOK * 8 * 4 <= 17 * MiB, "rope tables");
constexpr size_t WS_W = 18 * MiB;
constexpr size_t W_SBIN = WS_W, W_SBOUT = W_SBIN + 2ull * SBW * DM * 2, W_MLAIN = W_SBOUT + 2ull * DM * DM * 2, W_MLAQ = W_MLAIN + (size_t)MLAW * DM * 2,
                 W_MLAKV = W_MLAQ + 1536ull * 256 * 2, W_MLAOUT = W_MLAKV + 2048ull * 256 * 2, W_DSAIN = W_MLAOUT + (size_t)DM * DM * 2, W_DSAOUT = W_DSAIN + (size_t)DSAW * DM * 2,
                 W_FFNGU = W_DSAOUT + (size_t)DM * DM * 2, W_FFNDN = W_FFNGU + 2ull * 2 * DFF * DM * 2, W_MOEGU = W_FFNDN + 2ull * DM * DFF * 2,
                 W_MOEDN = W_MOEGU + 2ull * NEXP * 2 * DFFE * DM * 2, W_END = W_MOEDN + 2ull * NEXP * DM * DFFE * 2;
static_assert(W_END <= 211 * MiB, "weights");
constexpr size_t WS_H = 211 * MiB;
constexpr size_t WS_BIG = 275 * MiB;
constexpr size_t WS_BIG2 = 467 * MiB;
constexpr size_t WS_O = WS_BIG2 + 128 * MiB;
constexpr size_t WS_END = 659 * MiB;
constexpr size_t BIG_MLA_CIN = WS_BIG + 96 * MiB, BIG_DSA_MASK = WS_BIG + 144 * MiB;

constexpr int RING_OFF = 0, RING_BYTES = 131072;
constexpr int LDSCTL_OFF = RING_BYTES, MISC_OFF = LDSCTL_OFF + 320;
constexpr int LDS_BYTES = 147456;
constexpr int NWAVES = 8;

#define RLX_AGENT __ATOMIC_RELAXED, __HIP_MEMORY_SCOPE_AGENT
#define LDS_WAIT() asm volatile("s_waitcnt lgkmcnt(0)" ::: "memory")
#define VM_WAIT() asm volatile("s_waitcnt vmcnt(0)" ::: "memory")
#define LDS_BARRIER() do { asm volatile("s_waitcnt lgkmcnt(0)" ::: "memory"); __builtin_amdgcn_s_barrier(); asm volatile("" ::: "memory"); } while (0)
typedef __bf16 bf16v2_t __attribute__((ext_vector_type(2)));
__device__ __forceinline__ unsigned cvtpk_c(float lo, float hi) { const f32x2 f = {lo, hi}; const bf16v2_t v = __builtin_convertvector(f, bf16v2_t); return __builtin_bit_cast(unsigned, v); }
__device__ __forceinline__ unsigned cvtpk(float lo, float hi) { return cvtpk_c(lo, hi); }
__device__ __forceinline__ float bf2f(unsigned short h) { return __uint_as_float((unsigned)h << 16); }
__device__ __forceinline__ float bflo(unsigned w) { return __uint_as_float(w << 16); }
__device__ __forceinline__ float bfhi(unsigned w) { return __uint_as_float(w & 0xffff0000u); }
__device__ __forceinline__ int opaque_tid() { int t = threadIdx.x; asm volatile("" : "+v"(t)); return t; }
__device__ __forceinline__ float wave_sum(float v) {
#define WS_DPP(ctrl) v += __int_as_float(__builtin_amdgcn_update_dpp(0, __float_as_int(v), ctrl, 0xF, 0xF, true))
    WS_DPP(0xB1); WS_DPP(0x4E); WS_DPP(0x141); WS_DPP(0x140);
#undef WS_DPP
    { auto rr = __builtin_amdgcn_permlane16_swap(__float_as_uint(v), __float_as_uint(v), false, false); v = __uint_as_float(rr[0]) + __uint_as_float(rr[1]); }
    { auto rr = __builtin_amdgcn_permlane32_swap(__float_as_uint(v), __float_as_uint(v), false, false); v = __uint_as_float(rr[0]) + __uint_as_float(rr[1]); }
    return v;
}

#define XB_TMO      128
#define XB_XCNT(j)  (256  + 64 * (j))
#define XB_XSUB(j)  (1280 + 64 * (j))
#define XB_XGEN(j)  (2304 + 64 * (j))
#define XB_TOP      3328
#define XB_TOPGEN   3392
#define XCD_BAR_WORDS 3456
#define XB_SPIN_CAP (1u << 20)
__device__ __forceinline__ unsigned xb_ld(unsigned* p)              { return __hip_atomic_load(p, __ATOMIC_RELAXED, __HIP_MEMORY_SCOPE_AGENT); }
__device__ __forceinline__ unsigned xb_add(unsigned* p, unsigned v) { return __hip_atomic_fetch_add(p, v, __ATOMIC_RELAXED, __HIP_MEMORY_SCOPE_AGENT); }
__device__ __forceinline__ unsigned xb_xcc_id() { return (unsigned)__builtin_amdgcn_s_getreg((3 << 11) | 20) & 0xFu; }
#define XB_SPIN(cond, bar) do { unsigned _sp = 0; while (cond) { __builtin_amdgcn_s_sleep(1); \
    if ((++_sp & 255u) == 0u) { if (xb_ld(&(bar)[XB_TMO])) break; if (_sp > XB_SPIN_CAP) { atomicAdd(&(bar)[XB_TMO], 1u); break; } } } } while (0)
struct XcdBarrier { unsigned* bar; unsigned x; volatile LAS unsigned* st; };
__device__ __forceinline__ XcdBarrier xcd_barrier_post(unsigned* bar, volatile LAS unsigned* st) {
    XcdBarrier b; b.bar = bar; b.x = xb_xcc_id(); b.st = st;
    if (threadIdx.x == 0) (void)xb_add(&bar[XB_XCNT(b.x)], 1u);
    return b;
}
__device__ __forceinline__ void xcd_barrier_complete(unsigned* bar, unsigned x, unsigned& nloc, unsigned& nx) {
    const unsigned G = gridDim.x * gridDim.y * gridDim.z;
    unsigned sum, cnt, mine, sp = 0u;
    for (;;) {
        sum = 0u; cnt = 0u; mine = 0u;
#pragma unroll
        for (unsigned j = 0; j < 16; ++j) { const unsigned c = xb_ld(&bar[XB_XCNT(j)]); sum += c; cnt += (c > 0u) ? 1u : 0u; mine = (j == x) ? c : mine; }
        if (sum == G) break;
        __builtin_amdgcn_s_sleep(1);
        if ((++sp & 255u) == 0u) { if (xb_ld(&bar[XB_TMO])) break; if (sp > XB_SPIN_CAP) { atomicAdd(&bar[XB_TMO], 1u); break; } }
    }
    nloc = mine > 0u ? mine : 1u; nx = cnt > 0u ? cnt : 1u;
}
__device__ __forceinline__ void xcd_barrier(const XcdBarrier& b) {
    asm volatile("s_waitcnt vmcnt(0)" ::: "memory");
    __syncthreads();
    if (threadIdx.x == 0) {
        unsigned* bar = b.bar;
        __builtin_amdgcn_s_waitcnt(0);
        unsigned nloc = b.st[0], nx = b.st[1];
        if (nloc == 0u) { xcd_barrier_complete(bar, b.x, nloc, nx); b.st[0] = nloc; b.st[1] = nx; }
        const unsigned old = xb_add(&bar[XB_XSUB(b.x)], 1u);
        const unsigned gen = old / nloc;
        if (old + 1u == (gen + 1u) * nloc) {
            __builtin_amdgcn_fence(__ATOMIC_RELEASE, "agent");
            asm volatile("s_waitcnt vmcnt(0)" ::: "memory");
            const unsigned og = xb_add(&bar[XB_TOP], 1u);
            const unsigned tg = og / nx;
            if (og + 1u == (tg + 1u) * nx) xb_add(&bar[XB_TOPGEN], 1u);
            else XB_SPIN(xb_ld(&bar[XB_TOPGEN]) == tg, bar);
            __builtin_amdgcn_fence(__ATOMIC_ACQUIRE, "agent");
            xb_add(&bar[XB_XGEN(b.x)], 1u);
            asm volatile("s_waitcnt vmcnt(0)" ::: "memory");
        } else {
            XB_SPIN(xb_ld(&bar[XB_XGEN(b.x)]) == gen, bar);
            __builtin_amdgcn_fence(__ATOMIC_ACQUIRE, "agent");
            asm volatile("s_waitcnt vmcnt(0)" ::: "memory");
        }
    }
    __syncthreads();
}
namespace pg8 {
constexpr int BM = 256, BK = 64, HALF = 128, HTB = HALF * BK * 2, STAGE_BYTES = 8 * HTB, NXCD = 8, WGM = 8;
__host__ __device__ __forceinline__ int lds_byte(int r, int c) { const int st = (r >> 4) * 2 + (c >> 5), rr = r & 15, cc = c & 31, ob = rr * 64 + cc * 2; return st * 1024 + (ob ^ (((ob >> 9) & 1) << 5)); }
__host__ __device__ __forceinline__ void stage_rc(int b, int& R, int& C) { const int st = b / 1024, sb = b % 1024, swz = sb ^ (((sb >> 9) & 1) << 5); R = (st >> 1) * 16 + swz / 64; C = (st & 1) * 32 + (swz % 64) / 2; }
__host__ __device__ __forceinline__ int perm32(int rho) { const int n = rho >> 4, i = rho & 15; return 8 * (i >> 2) + 4 * n + (i & 3); }

struct Unit { int pm, pn, pc; };
struct Gemm { const bf16_t* A; const bf16_t* Bt; int lda, K; };

__device__ __forceinline__ bool tile_of(long L, int nM, int nN, int& pm, int& pn) {
    const int nwg = nM * nN; if (L >= nwg) return false;
    int wgid = (int)L; { const int q = nwg / NXCD, r = nwg % NXCD, xcd = wgid % NXCD, off = wgid / NXCD; wgid = (xcd < r ? xcd * (q + 1) : r * (q + 1) + (xcd - r) * q) + off; }
    const int nig = WGM * nN, gid = wgid / nig, fm = gid * WGM, gsz = (nM - fm) < WGM ? (nM - fm) : WGM;
    pm = fm + ((wgid % nig) % gsz); pn = (wgid % nig) / gsz; return true;
}
struct StaticOrder {
    int nM, nN, G, c;
    __device__ void init(int M, int N, int G_, int c_) { nM = M / BM; nN = N / BM; G = G_; c = c_; }
    __device__ __forceinline__ bool next(int i, Unit& u) const { int pm, pn; if (!tile_of((long)i * G + c, nM, nN, pm, pn)) return false; u.pm = pm; u.pn = pn; u.pc = pn; return true; }
};
struct GroupOrder {
    int nM, nN, G, c; int st[9];
    __device__ __forceinline__ bool next(int i, Unit& u) const {
        int pm, pn; if (!tile_of((long)i * G + c, nM, nN, pm, pn)) return false;
        int e = 0;
#pragma unroll
        for (int k = 1; k < 8; ++k) e += (pm >= st[k]) ? 1 : 0;
        u.pm = pm; u.pn = e * nN + pn; u.pc = pn; return true;
    }
};

struct EpiStore {
    bf16_t* O; int ldc;
    __device__ __forceinline__ void operator()(const f32x4 (&acc)[2][2][4][2], const Unit& u, int wr, int wc, int fr, int fq) const {
        const int row0 = u.pm * BM + wr * 64 + fr, col0 = u.pc * BM + wc * 32 + 8 * fq;
#pragma unroll
        for (int ai = 0; ai < 2; ++ai)
#pragma unroll
            for (int m = 0; m < 4; ++m) { bf16_t* rowp = O + (size_t)(row0 + ai * HALF + m * 16) * ldc + col0;
#pragma unroll
                for (int bj = 0; bj < 2; ++bj) { const f32x4 v0 = acc[ai][bj][m][0], v1 = acc[ai][bj][m][1];
                    u32x4 w; w.x = cvtpk_c(v0[0], v0[1]); w.y = cvtpk_c(v0[2], v0[3]); w.z = cvtpk_c(v1[0], v1[1]); w.w = cvtpk_c(v1[2], v1[3]);
                    *(u32x4*)(rowp + bj * HALF) = w; } }
    }
};
__device__ __forceinline__ float silu_mul(float a, float b) { return a * __builtin_amdgcn_rcpf(1.0f + __builtin_amdgcn_exp2f(-1.4426950408889634f * a)) * b; }
struct EpiSwiGLU {
    bf16_t* O; int ldc;
    __device__ __forceinline__ void operator()(const f32x4 (&acc)[2][2][4][2], const Unit& u, int wr, int wc, int fr, int fq) const {
        const int row0 = u.pm * BM + wr * 64 + fr, col0 = u.pc * HALF + wc * 32 + 8 * fq;
#pragma unroll
        for (int ai = 0; ai < 2; ++ai)
#pragma unroll
            for (int m = 0; m < 4; ++m) { bf16_t* rowp = O + (size_t)(row0 + ai * HALF + m * 16) * ldc + col0;
                const f32x4 a0 = acc[ai][0][m][0], a1 = acc[ai][0][m][1], b0 = acc[ai][1][m][0], b1 = acc[ai][1][m][1];
                u32x4 w; w.x = cvtpk_c(silu_mul(a0[0], b0[0]), silu_mul(a0[1], b0[1])); w.y = cvtpk_c(silu_mul(a0[2], b0[2]), silu_mul(a0[3], b0[3]));
                w.z = cvtpk_c(silu_mul(a1[0], b1[0]), silu_mul(a1[1], b1[1])); w.w = cvtpk_c(silu_mul(a1[2], b1[2]), silu_mul(a1[3], b1[3]));
                *(u32x4*)rowp = w; }
    }
};

constexpr int RI_OFF = 131072 + 8192;
template <class Epi, class Sched, bool ALIGN_EPI, bool GATHER = false>
__device__ __forceinline__ void gemm_phase(LAS unsigned char* lds, const Gemm g, const Sched& S, const Epi& E, const int* ridx = nullptr) {
    const int tid = opaque_tid(), wid = __builtin_amdgcn_readfirstlane(tid >> 6), lane = tid & 63, wr = wid >> 2, wc = wid & 3, fr = lane & 15, fq = lane >> 4;
    const int K = g.K, lda = g.lda, nt = K / BK;
    unsigned voffA[2], voffB[2];
#pragma unroll
    for (int i = 0; i < 2; ++i) { int R, C; stage_rc(tid * 16 + i * 8192, R, C); const int Rb = (R & ~31) + perm32(R & 31);
        voffA[i] = (unsigned)(R * lda + C) * 2u; voffB[i] = (unsigned)(Rb * K + C) * 2u; }
    unsigned vG[2][2]; int Rg, Cg; stage_rc(tid * 16, Rg, Cg);
    const unsigned c2g = (unsigned)Cg * 2u, rowb = (unsigned)lda * 2u;
    LAS const int* RI = (LAS const int*)(lds + RI_OFF);
    const size_t kstep = (size_t)(BK * 2);
    const size_t hstepA = (size_t)HALF * lda * 2, hstepB = (size_t)HALF * K * 2;
    const size_t tstepA = 2 * hstepA, tstepB = 2 * hstepB;
    const unsigned ldsw = (unsigned)wid * 1024u;
    const int aoff = lds_byte(wr * 64 + fr, fq * 8), boff = lds_byte(wc * 32 + fr, fq * 8);
#define PG8_SA(b, h) (((b) * 2 + (h)) * HTB)
#define PG8_SB(b, h) ((4 + (b) * 2 + (h)) * HTB)
#define PG8_STAGE(bufoff, gbase, voff) do { _Pragma("unroll") for (int _i = 0; _i < 2; ++_i) \
        __builtin_amdgcn_global_load_lds((const unsigned*)((const char*)(gbase) + (voff)[_i]), (LAS unsigned*)(lds + (bufoff) + ldsw + _i * 8192), 16, 0, 0); } while (0)
#define PG8_STAGE_A(bufoff, kptr, h) do { if constexpr (GATHER) PG8_STAGE(bufoff, kptr, vG[h]); else PG8_STAGE(bufoff, (kptr) + (h) * hstepA, voffA); } while (0)
#define PG8_LDA(dst, b, h) do { _Pragma("unroll") for (int m = 0; m < 4; ++m) _Pragma("unroll") for (int k = 0; k < 2; ++k) dst[m][k] = *(const LAS bf16x8*)(lds + PG8_SA(b, h) + aoff + m * 2048 + k * 1024); } while (0)
#define PG8_LDB(dst, b, h) do { _Pragma("unroll") for (int n = 0; n < 2; ++n) _Pragma("unroll") for (int k = 0; k < 2; ++k) dst[n][k] = *(const LAS bf16x8*)(lds + PG8_SB(b, h) + boff + n * 2048 + k * 1024); } while (0)
#define PG8_MMA(ai, bj, At, Bt) do { __builtin_amdgcn_s_setprio(1); _Pragma("unroll") for (int m = 0; m < 4; ++m) _Pragma("unroll") for (int n = 0; n < 2; ++n) _Pragma("unroll") for (int k = 0; k < 2; ++k) \
        acc[ai][bj][m][n] = __builtin_amdgcn_mfma_f32_16x16x32_bf16(Bt[n][k], At[m][k], acc[ai][bj][m][n], 0, 0, 0); __builtin_amdgcn_s_setprio(0); } while (0)
#define PG8_MFMA0(accv, b, a) asm("v_mfma_f32_16x16x32_bf16 %0, %1, %2, 0" : "+v"(accv) : "v"(b), "v"(a))
#define PG8_MMA_F(ai, bj, At, Bt) do { __builtin_amdgcn_s_setprio(1); \
        if (t == 0) { _Pragma("unroll") for (int m = 0; m < 4; ++m) _Pragma("unroll") for (int n = 0; n < 2; ++n) PG8_MFMA0(acc[ai][bj][m][n], Bt[n][0], At[m][0]); } \
        else { _Pragma("unroll") for (int m = 0; m < 4; ++m) _Pragma("unroll") for (int n = 0; n < 2; ++n) acc[ai][bj][m][n] = __builtin_amdgcn_mfma_f32_16x16x32_bf16(Bt[n][0], At[m][0], acc[ai][bj][m][n], 0, 0, 0); } \
        _Pragma("unroll") for (int m = 0; m < 4; ++m) _Pragma("unroll") for (int n = 0; n < 2; ++n) acc[ai][bj][m][n] = __builtin_amdgcn_mfma_f32_16x16x32_bf16(Bt[n][1], At[m][1], acc[ai][bj][m][n], 0, 0, 0); \
        __builtin_amdgcn_s_setprio(0); } while (0)
#define PG8_SP1_LOAD(a1p) do { PG8_LDB(B0, 0, 0); PG8_LDB(B1, 0, 1); PG8_SCHED; PG8_LDA(At, 0, 0); PG8_STAGE_A(PG8_SA(1, 1), a1p, 1); PG8_WAIT_V(8); PG8_WAIT_L(0); PG8_BAR; } while (0)
#define PG8_WAIT_V(n) asm volatile("s_waitcnt vmcnt(" #n ")" ::: "memory")
#define PG8_WAIT_L(n) asm volatile("s_waitcnt lgkmcnt(" #n ")" ::: "memory")
#define PG8_BAR __builtin_amdgcn_s_barrier()
#define PG8_SCHED __builtin_amdgcn_sched_barrier(0)
    Unit cur, nxt; int ui = 0;
    int vpm, vpn, vpc; { Unit mine; mine.pm = 0; mine.pn = 0; mine.pc = 0; const bool ok_ = S.next(lane, mine); vpm = ok_ ? mine.pm : -1; vpn = mine.pn; vpc = mine.pc; }
    auto unit_at = [&](int i, Unit& u) __attribute__((always_inline)) -> bool {
        if (i >= 64) return S.next(i, u);
        const int pm_ = __builtin_amdgcn_readlane(vpm, i); if (pm_ < 0) return false;
        u.pm = pm_; u.pn = __builtin_amdgcn_readlane(vpn, i); u.pc = __builtin_amdgcn_readlane(vpc, i); return true; };
    if (!unit_at(0, cur)) return;
    f32x4 acc[2][2][4][2];
#pragma unroll
    for (int a = 0; a < 2; ++a)
#pragma unroll
        for (int b = 0; b < 2; ++b)
#pragma unroll
            for (int m = 0; m < 4; ++m)
#pragma unroll
                for (int n = 0; n < 2; ++n) acc[a][b][m][n] = (f32x4){0.f, 0.f, 0.f, 0.f};
    bf16x8 At[4][2], B0[2][2], B1[2][2];
    const char* cA = GATHER ? (const char*)g.A : (const char*)g.A + (size_t)cur.pm * tstepA; const char* cB = (const char*)g.Bt + (size_t)cur.pn * tstepB;
    if constexpr (GATHER) {
#pragma unroll
        for (int h = 0; h < 2; ++h)
#pragma unroll
            for (int i = 0; i < 2; ++i) vG[h][i] = (unsigned)ridx[cur.pm * BM + h * HALF + Rg + 64 * i] * rowb + c2g;
    }
    PG8_STAGE(PG8_SB(0, 0), cB, voffB); PG8_STAGE(PG8_SB(0, 1), cB + hstepB, voffB); PG8_STAGE_A(PG8_SA(0, 0), cA, 0); PG8_STAGE_A(PG8_SA(0, 1), cA, 1);
    if (wr == 1) PG8_BAR;
    PG8_WAIT_V(2); PG8_BAR;
    PG8_STAGE(PG8_SB(1, 0), cB + kstep, voffB); PG8_STAGE_A(PG8_SA(1, 0), cA + kstep, 0); PG8_STAGE(PG8_SB(1, 1), cB + hstepB + kstep, voffB);
    PG8_WAIT_V(6); PG8_BAR;
    PG8_SP1_LOAD(cA + kstep);
    for (;;) {
        const bool has_next = unit_at(ui + 1, nxt);
        const char* nA = (has_next && !GATHER) ? (const char*)g.A + (size_t)nxt.pm * tstepA : cA;
        if constexpr (GATHER) { const int pmI = has_next ? nxt.pm : cur.pm;
            __builtin_amdgcn_global_load_lds((const unsigned*)(ridx + pmI * BM + (wid & 3) * 64 + lane), (LAS unsigned*)(lds + RI_OFF + (wid & 3) * 256), 4, 0, 0); }
        const char* nB = has_next ? (const char*)g.Bt + (size_t)nxt.pn * tstepB : cB;
        for (int t = 0; t < nt; t += 2) {
            const bool last = (t == nt - 2);
            const char* a1 = cA + (size_t)(t + 1) * kstep;
            const char* a2 = last ? nA : cA + (size_t)(t + 2) * kstep; const char* b2 = last ? nB : cB + (size_t)(t + 2) * kstep;
            const char* a3 = a2 + kstep; const char* b3 = b2 + kstep;
            if (t != 0) PG8_SP1_LOAD(a1);
            PG8_MMA_F(0, 0, At, B0); PG8_MMA_F(0, 1, At, B1); PG8_BAR; PG8_SCHED;
            if constexpr (GATHER) { if (last) {
#pragma unroll
                for (int h = 0; h < 2; ++h)
#pragma unroll
                    for (int i = 0; i < 2; ++i) vG[h][i] = (unsigned)RI[h * HALF + Rg + 64 * i] * rowb + c2g; }
                PG8_SCHED; }
            PG8_LDA(At, 0, 1); PG8_STAGE(PG8_SB(0, 0), b2, voffB); PG8_STAGE(PG8_SB(0, 1), b2 + hstepB, voffB); PG8_STAGE_A(PG8_SA(0, 0), a2, 0);
            PG8_WAIT_V(8); PG8_WAIT_L(0); PG8_BAR; PG8_MMA_F(1, 0, At, B0); PG8_MMA_F(1, 1, At, B1); PG8_BAR; PG8_SCHED;
            PG8_LDB(B0, 1, 0); PG8_LDB(B1, 1, 1); PG8_SCHED; PG8_LDA(At, 1, 0); PG8_STAGE_A(PG8_SA(0, 1), a2, 1);
            PG8_WAIT_V(8); PG8_WAIT_L(0); PG8_BAR; PG8_MMA(0, 0, At, B0); PG8_MMA(0, 1, At, B1); PG8_BAR; PG8_SCHED;
            PG8_LDA(At, 1, 1); PG8_STAGE(PG8_SB(1, 0), b3, voffB); PG8_STAGE(PG8_SB(1, 1), b3 + hstepB, voffB); PG8_STAGE_A(PG8_SA(1, 0), a3, 0);
            PG8_WAIT_V(8); PG8_WAIT_L(0); PG8_BAR; PG8_MMA(1, 0, At, B0); PG8_MMA(1, 1, At, B1); PG8_BAR; PG8_SCHED;
        }
        if constexpr (ALIGN_EPI) { if (wr == 0) PG8_BAR; }
        if (has_next) PG8_SP1_LOAD(nA + kstep);
        E(acc, cur, wr, wc, fr, fq);
        if (!has_next) break;
        cur = nxt; cA = nA; cB = nB; ++ui;
        if constexpr (ALIGN_EPI) { if (wr == 1) PG8_BAR; }
    }
    PG8_WAIT_V(0);
    if constexpr (!ALIGN_EPI) { if (wr == 0) PG8_BAR; }
    PG8_BAR;
#undef PG8_SA
#undef PG8_SB
#undef PG8_STAGE
#undef PG8_STAGE_A
#undef PG8_LDA
#undef PG8_LDB
#undef PG8_MMA
#undef PG8_MMA_F
#undef PG8_MFMA0
#undef PG8_SP1_LOAD
#undef PG8_WAIT_V
#undef PG8_WAIT_L
#undef PG8_BAR
#undef PG8_SCHED
}
}
namespace fa {
constexpr int SHM_V = 16384, SHM_K = 16384, SHM_KR = 8192;
constexpr int OFF_V = 0, OFF_K = 32768, OFF_KR = 65536, OFF_SCR = 81920, OFF_FLAG = OFF_SCR + 2048, FA_LDS = OFF_FLAG + 64;
#define KSWZ(row, colB) ((row) * 256 + ((colB) ^ (((row) & 7) << 4) ^ ((((row) >> 3) & 1) << 7)))
#define KRSWZ(row, colB) ((row) * 128 + ((colB) ^ ((((row) >> 1) & 7) << 4)))
#define SBAR() __builtin_amdgcn_sched_barrier(0)
__device__ __forceinline__ int v_st(int k, int c) { const int kk = (k & ~0xC) | ((k & 4) << 1) | ((k & 8) >> 1); return ((kk >> 3) * 4 + (c >> 5)) * 512 + ((kk & 7) * 32 + (c & 31)) * 2; }
__device__ __forceinline__ int v_rd_base(int lane) { return ((lane & 3) << 3) | (((lane >> 2) & 3) << 6) | (((lane >> 4) & 1) << 5) | (((lane >> 5) & 1) << 8); }
constexpr int v_rd_off(int d0, int ks, int half) { return d0 * 512 + ks * 4096 + half * 2048; }
__device__ __forceinline__ int crow(int r, int hi) { return (r & 3) + 8 * (r >> 2) + 4 * hi; }

struct AttnArgs {
    const bf16_t* Q; int qpitch, qhs;
    const bf16_t* K; int kpitch, khs;
    const bf16_t* V; int vpitch, vhs;
    const bf16_t* KR; int krpitch;
    bf16_t* O;
    unsigned* flag;
    const float* cosm; const float* sinm;
    const u64* mask;
    int kvdiv;
};

__device__ __forceinline__ void mask_causal(f32x16& p0, f32x16& p1, int dq) {
    const float NEG = -__builtin_inff();
#pragma unroll
    for (int r = 0; r < 16; ++r) { const int c = (r & 3) + 8 * (r >> 2); if (dq - c < 0) p0[r] = NEG; if (dq - c - 32 < 0) p1[r] = NEG; }
}
__device__ __forceinline__ void mask_bits(f32x16& p0, f32x16& p1, u64 mw, int hi) {
    const float NEG = -__builtin_inff();
    const unsigned w0 = (unsigned)mw >> (4 * hi), w1 = (unsigned)(mw >> 32) >> (4 * hi);
#pragma unroll
    for (int r = 0; r < 16; ++r) { const int c = (r & 3) + 8 * (r >> 2);
        const unsigned m0 = (unsigned)__builtin_amdgcn_sbfe((int)w0, c, 1), m1 = (unsigned)__builtin_amdgcn_sbfe((int)w1, c, 1), ninf = __float_as_uint(NEG);
        p0[r] = __uint_as_float(__builtin_amdgcn_bitop3_b32(__float_as_uint(p0[r]), m0, ninf, 0xE2)); p1[r] = __uint_as_float(__builtin_amdgcn_bitop3_b32(__float_as_uint(p1[r]), m1, ninf, 0xE2)); }
}
template <int SCALE_X1E6>
__device__ __forceinline__ void partialSM(f32x16& p0, f32x16& p1, float& m_reg, float& mn, float& alpha) {
    constexpr float SCALE = SCALE_X1E6 * 1e-6f, THR = 8.f;
    float pmax = p0[0];
#pragma unroll
    for (int r = 1; r < 16; ++r) pmax = fmaxf(pmax, p0[r]);
#pragma unroll
    for (int r = 0; r < 16; ++r) pmax = fmaxf(pmax, p1[r]);
    { auto rr = __builtin_amdgcn_permlane32_swap(__float_as_uint(pmax), __float_as_uint(pmax), false, false);
      pmax = fmaxf(__uint_as_float(rr[0]), __uint_as_float(rr[1])); }
    constexpr float C2 = 1.4426950408889634f * SCALE;
    if (__builtin_expect(__all((pmax - m_reg) * SCALE <= THR), 1)) { mn = m_reg; alpha = 1.f; }
    else { mn = fmaxf(m_reg, pmax); alpha = __builtin_amdgcn_exp2f((m_reg - mn) * C2); m_reg = mn; }
    const float mnL = -mn * C2;
#pragma unroll
    for (int r = 0; r < 16; ++r) p0[r] = fmaf(p0[r], C2, mnL);
#pragma unroll
    for (int r = 0; r < 16; ++r) p1[r] = fmaf(p1[r], C2, mnL);
#pragma unroll
    for (int r = 0; r < 16; ++r) p0[r] = __builtin_amdgcn_exp2f(p0[r]);
}
#define PK4(P, B_, OUT) do { unsigned a0 = cvtpk(P[B_+0], P[B_+1]), a1 = cvtpk(P[B_+2], P[B_+3]);                          \
        unsigned b0 = cvtpk(P[B_+4], P[B_+5]), b1 = cvtpk(P[B_+6], P[B_+7]);                                             \
        auto r0 = __builtin_amdgcn_permlane32_swap(a0, b0, false, false); auto r1 = __builtin_amdgcn_permlane32_swap(a1, b1, false, false); \
        u32x4 w = {r0[0], r1[0], r0[1], r1[1]}; OUT = *reinterpret_cast<bf16x8*>(&w); } while (0)
__device__ __forceinline__ void partialSM2(f32x16& p0, f32x16& p1, f32x16& negm, float& m_reg, float& seen, float& alpha) {
    constexpr float THRP = 8.f * 1.4426950408889634f;
    float pmax = p0[0];
#pragma unroll
    for (int r = 1; r < 16; ++r) pmax = fmaxf(pmax, p0[r]);
#pragma unroll
    for (int r = 0; r < 16; ++r) pmax = fmaxf(pmax, p1[r]);
    { auto rr = __builtin_amdgcn_permlane32_swap(__float_as_uint(pmax), __float_as_uint(pmax), false, false);
      pmax = fmaxf(__uint_as_float(rr[0]), __uint_as_float(rr[1])); }
    if (__builtin_expect(__all(seen != 0.f && pmax <= THRP), 1)) { alpha = 1.f; }
    else {
        float d, a;
        if (seen == 0.f) { const bool v = pmax > -__builtin_inff(); d = v ? pmax : 0.f; a = v ? 0.f : 1.f; seen = v ? 1.f : 0.f; }
        else { d = fmaxf(pmax, 0.f); a = __builtin_amdgcn_exp2f(-d); }
        alpha = a; m_reg += d;
#pragma unroll
        for (int r = 0; r < 16; ++r) { p0[r] -= d; p1[r] -= d; }
        const float nm = -m_reg;
#pragma unroll
        for (int r = 0; r < 16; ++r) negm[r] = nm;
    }
#pragma unroll
    for (int r = 0; r < 16; ++r) p0[r] = __builtin_amdgcn_exp2f(p0[r]);
}
__device__ __forceinline__ float fastSM(f32x16& p0, f32x16& p1) {
#pragma unroll
    for (int r = 0; r < 16; ++r) p0[r] = __builtin_amdgcn_exp2f(p0[r]);
#pragma unroll
    for (int r = 0; r < 16; ++r) p1[r] = __builtin_amdgcn_exp2f(p1[r]);
    float ps = 0;
#pragma unroll
    for (int r = 0; r < 16; ++r) ps += p0[r];
#pragma unroll
    for (int r = 0; r < 16; ++r) ps += p1[r];
    { auto rr = __builtin_amdgcn_permlane32_swap(__float_as_uint(ps), __float_as_uint(ps), false, false);
      ps = __uint_as_float(rr[0]) + __uint_as_float(rr[1]); }
    return ps;
}
__device__ __forceinline__ void finishSM(f32x16& p0, f32x16& p1, float alpha, float& l_reg, bf16x8& pa0, bf16x8& pa1, bf16x8& pa2, bf16x8& pa3) {
#pragma unroll
    for (int r = 0; r < 16; ++r) p1[r] = __builtin_amdgcn_exp2f(p1[r]);
    float ps = 0;
#pragma unroll
    for (int r = 0; r < 16; ++r) ps += p0[r];
#pragma unroll
    for (int r = 0; r < 16; ++r) ps += p1[r];
    { auto rr = __builtin_amdgcn_permlane32_swap(__float_as_uint(ps), __float_as_uint(ps), false, false);
      ps = __uint_as_float(rr[0]) + __uint_as_float(rr[1]); }
    l_reg = l_reg * alpha + ps;
    PK4(p0, 0, pa0); PK4(p0, 8, pa1); PK4(p1, 0, pa2); PK4(p1, 8, pa3);
}
__device__ __forceinline__ void sb_tile(f32x16& p0, f32x16& p1, int dq, float& P, bf16x8& pa0, bf16x8& pa1, bf16x8& pa2, bf16x8& pa3, const bool diag) {
    f32x16 f0, f1;
#pragma unroll
    for (int r = 0; r < 16; ++r) {
        { const float e = __builtin_amdgcn_exp2f(-p0[r]); const float rr = __builtin_amdgcn_rcpf(1.0f + e); f0[r] = 1.0f - rr; p0[r] = rr; }
        { const float e = __builtin_amdgcn_exp2f(-p1[r]); const float rr = __builtin_amdgcn_rcpf(1.0f + e); f1[r] = 1.0f - rr; p1[r] = rr; } }
    if (diag) { asm volatile("" ::: "memory");
#pragma unroll
        for (int r = 0; r < 16; ++r) { const int c = (r & 3) + 8 * (r >> 2); f0[r] = (dq - c > 0) ? f0[r] : 1.0f; f1[r] = (dq - c - 32 > 0) ? f1[r] : 1.0f; } }
    float S[16];
#pragma unroll
    for (int i = 0; i < 4; ++i) {
        const float g0 = (f0[4 * i] * f0[4 * i + 1]) * (f0[4 * i + 2] * f0[4 * i + 3]);
        const float g1 = (f1[4 * i] * f1[4 * i + 1]) * (f1[4 * i + 2] * f1[4 * i + 3]);
        auto r0 = __builtin_amdgcn_permlane32_swap(__float_as_uint(g0), __float_as_uint(g0), false, false);
        auto r1 = __builtin_amdgcn_permlane32_swap(__float_as_uint(g1), __float_as_uint(g1), false, false);
        S[2 * i] = __uint_as_float(r0[0]); S[2 * i + 1] = __uint_as_float(r0[1]);
        S[8 + 2 * i] = __uint_as_float(r1[0]); S[8 + 2 * i + 1] = __uint_as_float(r1[1]); }
    float Tg[16]; Tg[15] = 1.0f;
#pragma unroll
    for (int g = 14; g >= 0; --g) Tg[g] = Tg[g + 1] * S[g + 1];
    const float total = Tg[0] * S[0];
    const bool up = (__lane_id() & 32) != 0;
#pragma unroll
    for (int i = 0; i < 4; ++i) {
        { float t = P * Tg[2 * i + 1] * (up ? 1.0f : S[2 * i + 1]);
#pragma unroll
          for (int j = 3; j >= 0; --j) { const int r = 4 * i + j; const float a = p0[r] * t; t *= f0[r]; p0[r] = a; } }
        { float t = P * Tg[8 + 2 * i + 1] * (up ? 1.0f : S[8 + 2 * i + 1]);
#pragma unroll
          for (int j = 3; j >= 0; --j) { const int r = 4 * i + j; const float a = p1[r] * t; t *= f1[r]; p1[r] = a; } }
    }
    if (diag) { asm volatile("" ::: "memory");
#pragma unroll
        for (int r = 0; r < 16; ++r) { const int c = (r & 3) + 8 * (r >> 2); p0[r] = (dq - c > 0) ? p0[r] : 0.f; p1[r] = (dq - c - 32 > 0) ? p1[r] : 0.f; } }
    P *= total;
    PK4(p0, 0, pa0); PK4(p0, 8, pa1); PK4(p1, 0, pa2); PK4(p1, 8, pa3);
}
template <int KB, int NQ>
__device__ __forceinline__ void qkt(f32x16& p0, f32x16& p1, LAS unsigned char* lds, int r32, int hi, const bf16x8* qr, const f32x16& c0) {
    const int lb = (int)(unsigned)(uintptr_t)lds;
    int ka[8], kra[(NQ > 8) ? 4 : 1];
#pragma unroll
    for (int d0 = 0; d0 < 8; ++d0) ka[d0] = lb + KSWZ(r32, (d0 * 16 + hi * 8) * 2);
    if constexpr (NQ > 8) {
#pragma unroll
        for (int d0 = 0; d0 < 4; ++d0) kra[d0] = lb + OFF_KR + KRSWZ(r32, (d0 * 16 + hi * 8) * 2); }
    bf16x8 fa[3], fb[3];
#define KRD(dst, addr, off) asm volatile("ds_read_b128 %0, %1 offset:%2" : "=&v"(dst) : "v"(addr), "i"(off) : "memory")
#define QK_RD(d0) do { if constexpr ((d0) < 8) { KRD(fa[(d0) % 3], ka[(d0) < 8 ? (d0) : 0], OFF_K + KB * SHM_K); KRD(fb[(d0) % 3], ka[(d0) < 8 ? (d0) : 0], OFF_K + KB * SHM_K + 32 * 256); } \
                       else { KRD(fa[(d0) % 3], kra[(d0) >= 8 && NQ > 8 ? (d0) - 8 : 0], KB * SHM_KR); KRD(fb[(d0) % 3], kra[(d0) >= 8 && NQ > 8 ? (d0) - 8 : 0], KB * SHM_KR + 32 * 128); } } while (0)
#define QK_STEP(d0) do { if constexpr ((d0) < NQ) {                                                                              \
        if constexpr ((d0) + 2 < NQ) asm volatile("s_waitcnt lgkmcnt(4)" ::: "memory");                                          \
        else if constexpr ((d0) + 1 < NQ) asm volatile("s_waitcnt lgkmcnt(2)" ::: "memory");                                     \
        else asm volatile("s_waitcnt lgkmcnt(0)" ::: "memory");                                                                  \
        SBAR();                                                                                                                  \
        if constexpr ((d0) == 0) { p0 = __builtin_amdgcn_mfma_f32_32x32x16_bf16(fa[0], qr[0], c0, 0, 0, 0); p1 = __builtin_amdgcn_mfma_f32_32x32x16_bf16(fb[0], qr[0], c0, 0, 0, 0); }   \
        else { p0 = __builtin_amdgcn_mfma_f32_32x32x16_bf16(fa[(d0) % 3], qr[(d0) < NQ ? (d0) : 0], p0, 0, 0, 0);                \
               p1 = __builtin_amdgcn_mfma_f32_32x32x16_bf16(fb[(d0) % 3], qr[(d0) < NQ ? (d0) : 0], p1, 0, 0, 0); }              \
        SBAR();                                                                                                                  \
        if constexpr ((d0) + 3 < NQ) QK_RD((d0) + 3); } } while (0)
    QK_RD(0); QK_RD(1); QK_RD(2);
    QK_STEP(0); QK_STEP(1); QK_STEP(2); QK_STEP(3); QK_STEP(4); QK_STEP(5); QK_STEP(6); QK_STEP(7); QK_STEP(8); QK_STEP(9); QK_STEP(10); QK_STEP(11);
#undef QK_STEP
#undef QK_RD
#undef KRD
}
template <int VB>
__device__ __forceinline__ void pv_tile(f32x16* o, int vb0, bf16x8 pa0, bf16x8 pa1, bf16x8 pa2, bf16x8 pa3) {
#define TRRD(dst, off) asm volatile("ds_read_b64_tr_b16 %0, %1 offset:%2" : "=&v"(dst) : "v"(vb0), "i"(off) : "memory")
#define PV_RD(S, d0) do { constexpr int b_ = OFF_V + VB * SHM_V + v_rd_off(d0, 0, 0); \
        TRRD(S##l0, b_); TRRD(S##h0, b_ + 2048); TRRD(S##l1, b_ + 4096); TRRD(S##h1, b_ + 6144); TRRD(S##l2, b_ + 8192); TRRD(S##h2, b_ + 10240); TRRD(S##l3, b_ + 12288); TRRD(S##h3, b_ + 14336); } while (0)
#define PV_MM(S, d0) do { \
        o[d0] = __builtin_amdgcn_mfma_f32_32x32x16_bf16(pa0, (bf16x8){S##l0[0], S##l0[1], S##l0[2], S##l0[3], S##h0[0], S##h0[1], S##h0[2], S##h0[3]}, o[d0], 0, 0, 0);   \
        o[d0] = __builtin_amdgcn_mfma_f32_32x32x16_bf16(pa1, (bf16x8){S##l1[0], S##l1[1], S##l1[2], S##l1[3], S##h1[0], S##h1[1], S##h1[2], S##h1[3]}, o[d0], 0, 0, 0);   \
        o[d0] = __builtin_amdgcn_mfma_f32_32x32x16_bf16(pa2, (bf16x8){S##l2[0], S##l2[1], S##l2[2], S##l2[3], S##h2[0], S##h2[1], S##h2[2], S##h2[3]}, o[d0], 0, 0, 0);   \
        o[d0] = __builtin_amdgcn_mfma_f32_32x32x16_bf16(pa3, (bf16x8){S##l3[0], S##l3[1], S##l3[2], S##l3[3], S##h3[0], S##h3[1], S##h3[2], S##h3[3]}, o[d0], 0, 0, 0); } while (0)
#define PV_W(n) do { asm volatile("s_waitcnt lgkmcnt(" #n ")" ::: "memory"); SBAR(); } while (0)
    s16x4 Al0, Al1, Al2, Al3, Ah0, Ah1, Ah2, Ah3, Bl0, Bl1, Bl2, Bl3, Bh0, Bh1, Bh2, Bh3;
    PV_RD(A, 0); PV_RD(B, 1); PV_W(8); PV_MM(A, 0); SBAR();
    PV_RD(A, 2); PV_W(8); PV_MM(B, 1); SBAR();
    PV_RD(B, 3); PV_W(8); PV_MM(A, 2); SBAR();
    PV_W(0); PV_MM(B, 3);
#undef PV_W
#undef PV_MM
#undef PV_RD
#undef TRRD
}

template <int MODE, bool FAST = false>
__device__ __forceinline__ void attn_unit(LAS unsigned char* lds, const AttnArgs& A, int b, int h, int qb) {
    constexpr int NQ = (MODE == 1) ? 12 : 8;
    constexpr int SCALE6 = (MODE == 1) ? 72169 : 88388;
    const int tid = opaque_tid(), wid = __builtin_amdgcn_readfirstlane(tid >> 6), lane = tid & 63, r32 = lane & 31, hi = lane >> 5;
    const int q0 = qb * 256, qw0 = q0 + wid * 32, qpos = qw0 + r32;
    const size_t tok0 = (size_t)b * SEQ;
    LAS float* wsf = (LAS float*)(lds + OFF_SCR) + wid * 64; LAS float* li_l = wsf; LAS float* al_l = wsf + 32;
    volatile LAS int* flg = (volatile LAS int*)(lds + OFF_FLAG);
    bf16x8 qr[NQ];
    { const bf16_t* qrow = A.Q + (tok0 + qpos) * (size_t)A.qpitch + (size_t)h * A.qhs + hi * 8;
#pragma unroll
      for (int d0 = 0; d0 < NQ; ++d0) qr[d0] = *(const bf16x8*)(qrow + d0 * 16); }
    constexpr float QC2 = 1.4426950408889634f * (SCALE6 * 1e-6f);
    {
#pragma unroll
        for (int d0 = 0; d0 < 8; ++d0) { const u32x4 x = *reinterpret_cast<u32x4*>(&qr[d0]); u32x4 y;
#pragma unroll
            for (int w = 0; w < 4; ++w) y[w] = cvtpk(bflo(x[w]) * QC2, bfhi(x[w]) * QC2);
            qr[d0] = *reinterpret_cast<bf16x8*>(&y); }
    }
    if constexpr (MODE == 1) {
        const float* cs = A.cosm + (tok0 + qpos) * 32 + hi * 8; const float* sn = A.sinm + (tok0 + qpos) * 32 + hi * 8;
#pragma unroll
        for (int c2 = 0; c2 < 2; ++c2) {
            const f32x4 ca = *(const f32x4*)(cs + 16 * c2), cb = *(const f32x4*)(cs + 16 * c2 + 4), sa = *(const f32x4*)(sn + 16 * c2), sb = *(const f32x4*)(sn + 16 * c2 + 4);
            const u32x4 x1 = *reinterpret_cast<u32x4*>(&qr[8 + c2]), x2 = *reinterpret_cast<u32x4*>(&qr[10 + c2]);
            u32x4 y1, y2;
#pragma unroll
            for (int w = 0; w < 4; ++w) {
                const float c0 = (w < 2) ? ca[2 * w] : cb[2 * w - 4], c1 = (w < 2) ? ca[2 * w + 1] : cb[2 * w - 3];
                const float s0 = (w < 2) ? sa[2 * w] : sb[2 * w - 4], s1 = (w < 2) ? sa[2 * w + 1] : sb[2 * w - 3];
                const float a0 = bflo(x1[w]), a1 = bfhi(x1[w]), b0 = bflo(x2[w]), b1 = bfhi(x2[w]);
                y1[w] = cvtpk((a0 * c0 - b0 * s0) * QC2, (a1 * c1 - b1 * s1) * QC2); y2[w] = cvtpk((b0 * c0 + a0 * s0) * QC2, (b1 * c1 + a1 * s1) * QC2); }
            qr[8 + c2] = *reinterpret_cast<bf16x8*>(&y1); qr[10 + c2] = *reinterpret_cast<bf16x8*>(&y2); }
    }
    const int kvh = h / A.kvdiv;
    const bf16_t* Kg = A.K + (size_t)kvh * A.khs; const bf16_t* Vg = A.V + (size_t)kvh * A.vhs;
    int koff[2], voff[2], kroff = 0;
#pragma unroll
    for (int i = 0; i < 2; ++i) { const int q = (wid * 2 + i) * 1024 + lane * 16;
        { const int row = q >> 8, colB = (q & 255) ^ ((row & 7) << 4) ^ (((row >> 3) & 1) << 7); koff[i] = row * A.kpitch + (colB >> 1); }
        { const int st = q >> 9, kk = ((st >> 2) << 3) | ((q & 511) >> 6), k = (kk & ~0xC) | ((kk & 4) << 1) | ((kk & 8) >> 1), c = (st & 3) * 32 + ((q & 63) >> 1); voff[i] = k * A.vpitch + c; } }
    if constexpr (MODE == 1) { const int q = wid * 1024 + lane * 16, row = q >> 7, colB = (q & 127) ^ (((row >> 1) & 7) << 4); kroff = row * A.krpitch + (colB >> 1); }
    const int vb0 = (int)(unsigned)(uintptr_t)lds + v_rd_base(lane);
    u64 mw_cur = 0, mw_nxt = 0;
    const u64* mrow = nullptr;
    if constexpr (MODE == 2) mrow = A.mask + (size_t)b * 128 * SEQ;
    const unsigned mqoff = (unsigned)qpos * 8u;
#define GLDS(src, dst) __builtin_amdgcn_global_load_lds((const unsigned*)(src), (LAS unsigned*)(dst), 16, 0, 0)
    const __amdgpu_buffer_rsrc_t rsK = __builtin_amdgcn_make_buffer_rsrc((void*)Kg, 0, 0x7fffffff, 0x00020000), rsV = __builtin_amdgcn_make_buffer_rsrc((void*)Vg, 0, 0x7fffffff, 0x00020000);
    const __amdgpu_buffer_rsrc_t rsR = __builtin_amdgcn_make_buffer_rsrc((void*)((MODE == 1) ? A.KR : Kg), 0, 0x7fffffff, 0x00020000);
#define BLDS(rs, soff, voff, dst) __builtin_amdgcn_raw_ptr_buffer_load_lds(rs, (LAS void*)(dst), 16, (int)(voff), (int)(soff), 0, 0)
    constexpr bool SREG = false;
    u32x4 sk[2], sv[2], skr;
#define LOADT(j, bf) do { const size_t t0_ = tok0 + (size_t)(j) * 64;                                                           \
        _Pragma("unroll") for (int i_ = 0; i_ < 2; ++i_) {                                                                      \
            if constexpr (SREG) { sk[i_] = *(const u32x4*)(Kg + t0_ * A.kpitch + koff[i_]); sv[i_] = *(const u32x4*)(Vg + t0_ * A.vpitch + voff[i_]); } \
            else { BLDS(rsK, (unsigned)t0_ * (unsigned)A.kpitch * 2u, (unsigned)(koff[i_] * 2), lds + OFF_K + (bf) * SHM_K + (wid * 2 + i_) * 1024);   \
                   BLDS(rsV, (unsigned)t0_ * (unsigned)A.vpitch * 2u, (unsigned)(voff[i_] * 2), lds + OFF_V + (bf) * SHM_V + (wid * 2 + i_) * 1024); } }   \
        if constexpr (MODE == 1) { if constexpr (SREG) skr = *(const u32x4*)(A.KR + t0_ * A.krpitch + kroff); else BLDS(rsR, (unsigned)t0_ * (unsigned)A.krpitch * 2u, (unsigned)(kroff * 2), lds + OFF_KR + (bf) * SHM_KR + wid * 1024); } \
        if constexpr (MODE == 2) mw_nxt = *(const u64*)((const char*)(mrow + (size_t)(j) * SEQ) + mqoff); } while (0)
#define WRITET(bf) do { if constexpr (SREG) {                                                                                   \
        _Pragma("unroll") for (int i_ = 0; i_ < 2; ++i_) {                                                                      \
            *(LAS u32x4*)(lds + OFF_K + (bf) * SHM_K + (wid * 2 + i_) * 1024 + lane * 16) = sk[i_];                             \
            *(LAS u32x4*)(lds + OFF_V + (bf) * SHM_V + (wid * 2 + i_) * 1024 + lane * 16) = sv[i_]; }                           \
        if constexpr (MODE == 1) *(LAS u32x4*)(lds + OFF_KR + (bf) * SHM_KR + wid * 1024 + lane * 16) = skr; } } while (0)
    const int NT = 4 * qb + 4;
    bool bad = false;
    float m_reg = (MODE == 0) ? -1e30f : 0.f, l_reg = 0.f, Rsb = 1.0f, seen = 0.f; f32x16 o[4] = {}; f32x16 negm = {};
#define TILE_OF(it) ((MODE == 0) ? (NT - 1 - (it)) : (it))
    LOADT(TILE_OF(0), 0); mw_cur = mw_nxt; WRITET(0);
    VM_WAIT(); __syncthreads();
    bool stop = false;
#define STEP(BUF, it) do {                                                                                                      \
        const int j_ = TILE_OF(it), kb_ = j_ * 64; const bool more_ = (it) + 1 < NT;                                            \
        if (more_) LOADT(TILE_OF((it) + 1), (BUF) ^ 1);                                                                         \
        SBAR();                                                                                                                 \
        const bool act_ = (MODE == 0) ? (kb_ <= qw0 + 30 && !__all(Rsb < 1e-37f)) : (kb_ <= qw0 + 31);     \
        if (act_) {                                                                                                             \
            f32x16 p0, p1; bf16x8 pa0, pa1, pa2, pa3;                                                                           \
            qkt<BUF, NQ>(p0, p1, lds, r32, hi, qr, negm);                                                                       \
            if constexpr (MODE == 0) { sb_tile(p0, p1, qpos - kb_ - 4 * hi, Rsb, pa0, pa1, pa2, pa3, kb_ + 63 > qw0); }                \
            else { float mn_, al_;                                                                                              \
                if constexpr (MODE == 1) { if (kb_ + 63 > qw0) { asm volatile("" ::: "memory");     mask_causal(p0, p1, qpos - kb_ - 4 * hi); } }                      \
                else mask_bits(p0, p1, mw_cur, hi);                                                                             \
                if constexpr (FAST) { const float ps_ = fastSM(p0, p1); bad = bad || !(ps_ < 1.1529215e18f); l_reg += ps_; (void)mn_; (void)al_;   \
                    PK4(p0, 0, pa0); PK4(p0, 8, pa1); PK4(p1, 0, pa2); PK4(p1, 8, pa3); }                                       \
                else { partialSM2(p0, p1, negm, m_reg, seen, al_); (void)mn_; finishSM(p0, p1, al_, l_reg, pa0, pa1, pa2, pa3); \
                    if (__any(al_ < 1.f)) { if (hi == 0) al_l[r32] = al_; LDS_WAIT();                                           \
                        _Pragma("unroll") for (int d_ = 0; d_ < 4; ++d_) _Pragma("unroll") for (int r = 0; r < 16; ++r) o[d_][r] *= al_l[crow(r, hi)]; } } }   \
            SBAR(); pv_tile<BUF>(o, vb0, pa0, pa1, pa2, pa3);                                                                   \
        }                                                                                                                       \
        SBAR();                                                                                                                 \
        if (more_) { WRITET((BUF) ^ 1); mw_cur = mw_nxt; }                                                                      \
        if constexpr (MODE == 0) { const bool fin_ = __all(Rsb < 1e-37f) != 0; if (lane == 0) flg[((it) & 1) * 8 + wid] = fin_ ? 1 : 0; }   \
        VM_WAIT(); __syncthreads();                                                                                             \
        if constexpr (MODE == 0) { int all_ = 1; _Pragma("unroll") for (int w_ = 0; w_ < 8; ++w_) all_ &= flg[((it) & 1) * 8 + w_]; stop = all_ != 0; }   \
    } while (0)
    for (int it = 0; it < NT; it += 2) {
        STEP(0, it); if (stop) break;
        if (it + 1 < NT) { STEP(1, it + 1); if (stop) break; }
    }
#undef STEP
#undef LOADT
#undef WRITET
#undef GLDS
#undef BLDS
#undef TILE_OF
    if constexpr (MODE != 0 && FAST) {
        bad = bad || !(l_reg > 8.6736174e-19f);
        if (__any(bad) && lane == 0) __hip_atomic_store(A.flag, 1u, __ATOMIC_RELAXED, __HIP_MEMORY_SCOPE_AGENT);
    }
    float rli[16];
    if constexpr (MODE != 0) {
        if (hi == 0) li_l[r32] = l_reg; LDS_WAIT();
#pragma unroll
        for (int r = 0; r < 16; ++r) rli[r] = __builtin_amdgcn_rcpf(li_l[crow(r, hi)]);
    }
    bf16_t* Ow = A.O + (tok0 + qw0) * 1024 + (size_t)h * 128;
    LAS unsigned char* stg = lds + wid * (32 * 272);
#pragma unroll
    for (int r = 0; r < 16; ++r) { const int orow = crow(r, hi);
#pragma unroll
        for (int d0 = 0; d0 < 4; ++d0) { float v = o[d0][r]; if constexpr (MODE != 0) v *= rli[r];
            *(LAS unsigned short*)(stg + orow * 272 + (d0 * 32 + r32) * 2) = (unsigned short)(cvtpk(v, 0.f) & 0xffffu); } }
    LDS_WAIT();
#pragma unroll
    for (int i = 0; i < 8; ++i) { const int row = 4 * i + (lane >> 4), ch = lane & 15;
        const u32x4 w = *(const LAS u32x4*)(stg + row * 272 + ch * 16);
        *(u32x4*)(Ow + (size_t)row * 1024 + ch * 8) = w; }
    LDS_BARRIER();
}

template <int MODE, bool FAST = false>
__device__ __forceinline__ void attn_phase(LAS unsigned char* lds, const AttnArgs& A, int vcu, int G) {
    constexpr int NITEM = NB * 8 * 16;
    for (int L = vcu; L < NITEM; L += G) {
        const int bh = L >> 4, x = L & 15, b = bh >> 3, h = bh & 7;
        attn_unit<MODE, FAST>(lds, A, b, h, 31 - x);
        attn_unit<MODE, FAST>(lds, A, b, h, x);
    }
}
}
__device__ __forceinline__ void transpose_item(const float* W, int K, int N, bf16_t* WT, int Kp, int mode, int F, LAS float* scr, int item, int lane) {
    const int nblk = (N + 31) >> 5, kb = item / nblk, nb = item - kb * nblk, k0 = 64 * kb, n0 = 32 * nb;
    int nn = n0 + (lane & 31); if (nn > N - 1) nn = N - 1;
#pragma unroll 8
    for (int i = 0; i < 32; ++i) { const int kk = 2 * i + (lane >> 5); scr[kk * 33 + (lane & 31)] = W[(size_t)(k0 + kk) * N + nn]; }
    LDS_WAIT(); asm volatile("" ::: "memory");
    const int c = lane & 7;
#pragma unroll
    for (int j = 0; j < 4; ++j) { const int n = (lane >> 3) + 8 * j; const LAS float* s = scr + (8 * c) * 33 + n;
        int row = n0 + n;
        if (mode == 1) { const int mloc = row < F ? row : row - F; row = (mloc >> 7) * 256 + (mloc & 127) + (row < F ? 0 : 128); }
        u32x4 o; o.x = cvtpk(s[0 * 33], s[1 * 33]); o.y = cvtpk(s[2 * 33], s[3 * 33]); o.z = cvtpk(s[4 * 33], s[5 * 33]); o.w = cvtpk(s[6 * 33], s[7 * 33]);
        *(u32x4*)(WT + (size_t)row * Kp + k0 + 8 * c) = o; }
    LDS_WAIT(); asm volatile("" ::: "memory");
}
struct WDesc { const float* src; bf16_t* dst; int nmat, K, N, Kp, mode, F, npad; };
__device__ __forceinline__ int wdesc_items(const WDesc& d) { return d.nmat * (d.K >> 6) * ((d.N + 31) >> 5); }

__device__ __forceinline__ void prologue_phase(LAS unsigned char* lds, const float* const* in, const int* positions, unsigned char* ws, int vcu, int G) {
    const int tid = opaque_tid(), lane = tid & 63, wave = __builtin_amdgcn_readfirstlane(tid >> 6);
    {
        LAS float* cond = (LAS float*)lds;
        LAS float* red = (LAS float*)(lds + 16384);
        const float* c = in[1]; const float* ada_w = in[3]; const float* ada_b = in[4]; float* MOD = (float*)(ws + WS_MOD);
        bool have = false;
        for (int item = vcu; item < 96; item += G) {
            if (!have) { for (int u = tid; u < 4096; u += 512) { const float v = c[u]; cond[u] = v / (1.0f + __expf(-v)); } have = true; }
            __syncthreads();
            const int l = item / 24, ct = item - l * 24;
            f32x4 acc[4];
#pragma unroll
            for (int b = 0; b < 4; ++b) acc[b] = (f32x4){0.f, 0.f, 0.f, 0.f};
            const float* wp = ada_w + ((size_t)l * 1024 + wave * 128) * 6144 + ct * 256 + 4 * lane;
#pragma unroll 8
            for (int k = 0; k < 128; ++k) { const f32x4 wv = *(const f32x4*)(wp + (size_t)k * 6144);
#pragma unroll
                for (int b = 0; b < 4; ++b) acc[b] += wv * cond[b * 1024 + wave * 128 + k]; }
#pragma unroll
            for (int b = 0; b < 4; ++b) *(LAS f32x4*)(red + ((wave * 4 + b) * 256 + 4 * lane)) = acc[b];
            __syncthreads();
#pragma unroll
            for (int h2 = 0; h2 < 2; ++h2) { const int idx = tid + 512 * h2, b = idx >> 8, col = idx & 255; float s = ada_b[l * 6144 + ct * 256 + col];
#pragma unroll
                for (int w = 0; w < 8; ++w) s += red[(w * 4 + b) * 256 + col];
                MOD[((size_t)l * 4 + b) * 6144 + ct * 256 + col] = s; }
            __syncthreads();
        }
        __syncthreads();
    }
    {
        LAS float* scr = (LAS float*)(lds + wave * 16384);
        const int gw = vcu * NWAVES + wave, NGW = G * NWAVES;
        WDesc D[12];
        D[0] = WDesc{in[6], (bf16_t*)(ws + W_SBIN), 2, 1024, SBW, 1024, 0, 0, SBW};
        D[1] = WDesc{in[7], (bf16_t*)(ws + W_SBOUT), 2, 1024, 1024, 1024, 0, 0, 1024};
        D[2] = WDesc{in[8], (bf16_t*)(ws + W_MLAIN), 1, 1024, MLAW_REAL, 1024, 0, 0, MLAW};
        D[3] = WDesc{in[10], (bf16_t*)(ws + W_MLAQ), 1, 256, 1536, 256, 0, 0, 1536};
        D[4] = WDesc{in[12], (bf16_t*)(ws + W_MLAKV), 1, 128, 2048, 128, 0, 0, 2048};
        D[5] = WDesc{in[13], (bf16_t*)(ws + W_MLAOUT), 1, 1024, 1024, 1024, 0, 0, 1024};
        D[6] = WDesc{in[14], (bf16_t*)(ws + W_DSAIN), 1, 1024, DSAW_REAL, 1024, 0, 0, DSAW};
        D[7] = WDesc{in[16], (bf16_t*)(ws + W_DSAOUT), 1, 1024, 1024, 1024, 0, 0, 1024};
        D[8] = WDesc{in[17], (bf16_t*)(ws + W_FFNGU), 2, 1024, 2 * DFF, 1024, 1, DFF, 2 * DFF};
        D[9] = WDesc{in[18], (bf16_t*)(ws + W_FFNDN), 2, DFF, 1024, DFF, 0, 0, 1024};
        D[10] = WDesc{in[21], (bf16_t*)(ws + W_MOEGU), 16, 1024, 2 * DFFE, 1024, 1, DFFE, 2 * DFFE};
        D[11] = WDesc{in[22], (bf16_t*)(ws + W_MOEDN), 16, DFFE, 1024, DFFE, 0, 0, 1024};
        int total = 0;
#pragma unroll
        for (int d = 0; d < 12; ++d) total += wdesc_items(D[d]);
        for (int it = gw; it < total; it += NGW) {
            int r = it; const float* src = nullptr; bf16_t* dst = nullptr; int K = 0, N = 0, Kp = 0, mode = 0, F = 0; bool found = false;
#pragma unroll
            for (int d = 0; d < 12; ++d) { const int ni = wdesc_items(D[d]);
                if (!found) { if (r < ni) { const int per = ni / D[d].nmat, mi = r / per; r -= mi * per;
                        src = D[d].src + (size_t)mi * D[d].K * D[d].N; dst = D[d].dst + (size_t)mi * D[d].npad * D[d].Kp; K = D[d].K; N = D[d].N; Kp = D[d].Kp; mode = D[d].mode; F = D[d].F; found = true; }
                    else r -= ni; } }
            transpose_item(src, K, N, dst, Kp, mode, F, scr, r, lane);
        }
        float* cosm = (float*)(ws + RP_COSM); float* sinm = (float*)(ws + RP_SINM); float* cosa = (float*)(ws + RP_COSA); float* sina = (float*)(ws + RP_SINA);
        float* cosi = (float*)(ws + RP_COSI); float* sini = (float*)(ws + RP_SINI);
        int j = lane, rot = 64; float* ct = cosm; float* stb = sinm; int nf = 32;
        if (lane >= 48) { j = lane - 48; rot = 16; ct = cosi; stb = sini; nf = 8; }
        else if (lane >= 32) { j = lane - 32; rot = 32; ct = cosa; stb = sina; nf = 16; }
        const float inv = (float)exp2(-((double)(2 * j) / (double)rot) * 18.931568569324174);
        for (int m = gw; m < NTOK; m += NGW) {
            const float ang = (float)positions[m] * inv;
            double rev = (double)ang * 0.15915494309189535; rev -= floor(rev);
            const float rf = (float)rev;
            if (lane < 56) { ct[(size_t)m * nf + j] = __builtin_amdgcn_cosf(rf); stb[(size_t)m * nf + j] = __builtin_amdgcn_sinf(rf); }
        }
    }
}

struct ThinArgs {
    const float* xsrc; const bf16_t* xsrc16; float* xdst; bf16_t* xdst16; const bf16_t* H; bf16_t* Hout;
    int has_y, ymode, has_next, router;
    const float* gate; const float* gpost;
    const float* nsc; const float* nsh; const float* gpre;
    const bf16_t* OUTR; const int* SLOT; const float* GATEV;
    const float* wr; const float* br; int* SEL; float* GATEO; int* CCNT;
};
#ifndef THIN_DEEP_SEL
#define THIN_DEEP_SEL false
#endif
template <bool X32, bool HAS_Y, int YMODE, bool HAS_NEXT, bool ROUTER, bool XDST32>
__device__ __forceinline__ void thin_phase(LAS unsigned char* lds, const ThinArgs& A, int vcu, int G) {
    const int tid = opaque_tid(), lane = tid & 63, wave = __builtin_amdgcn_readfirstlane(tid >> 6);
    constexpr bool THIN_DEEP = THIN_DEEP_SEL;
    LAS float* Wt = (LAS float*)lds;
    LAS int* lcnt = (LAS int*)(lds + 32768);
    if (ROUTER) { for (int u = tid; u < 8192; u += 512) { const int k = u >> 3, e = u & 7; Wt[e * 1024 + k] = A.wr[u]; } }
    for (int gwi = vcu * NWAVES + wave; gwi < NTOK / 16; gwi += G * NWAVES) {
        if (ROUTER) { if (tid < 8) lcnt[tid] = 0; __syncthreads(); }
        const int m0 = gwi * 16, b = m0 >> 13;
        f32x4 q1[4], q2[4], q3[4], q4[4], q5[4];
#pragma unroll
        for (int j = 0; j < 4; ++j) { const int col = 4 * lane + 256 * j;
            if (HAS_Y) { q1[j] = *(const f32x4*)(A.gate + (size_t)b * 6144 + col); q2[j] = *(const f32x4*)(A.gpost + col); }
            if (HAS_NEXT) { q3[j] = *(const f32x4*)(A.gpre + col); q4[j] = *(const f32x4*)(A.nsc + (size_t)b * 6144 + col); q5[j] = *(const f32x4*)(A.nsh + (size_t)b * 6144 + col); } }
        f32x4 a1[4], a2[4], a3[4];
        int sl0 = 0, sl1 = 0; float gg0 = 0.f, gg1 = 0.f;
        if (HAS_Y && YMODE == 1 && lane < 16) { sl0 = A.SLOT[2 * (m0 + lane)]; sl1 = A.SLOT[2 * (m0 + lane) + 1]; gg0 = A.GATEV[2 * (m0 + lane)]; gg1 = A.GATEV[2 * (m0 + lane) + 1]; }
        float brv[8];
#pragma unroll
        for (int e = 0; e < 8; ++e) brv[e] = ROUTER ? A.br[e] : 0.f;
        f32x4 nxfA[4], nxfB[4], nxfC[4], nxfD[4]; u32x2 nxhA[4], nxhB[4], nxhC[4], nxhD[4], ny0A[4], ny0B[4], ny0C[4], ny0D[4], ny1A[4], ny1B[4], ny1C[4], ny1D[4];
#define THIN_LOAD(P, rr_) do { const int r_ = (rr_) < 15 ? (rr_) : 15; const int m_ = m0 + r_;                                  \
            _Pragma("unroll") for (int j = 0; j < 4; ++j) {                                                                     \
                if (X32) nxf##P[j] = *(const f32x4*)(A.xsrc + (size_t)m_ * 1024 + 4 * lane + 256 * j);                       \
                else nxh##P[j] = *(const u32x2*)(A.xsrc16 + (size_t)m_ * 1024 + 4 * lane + 256 * j); }                          \
            if (HAS_Y) { if (YMODE == 0) { _Pragma("unroll") for (int j = 0; j < 4; ++j) ny0##P[j] = *(const u32x2*)(A.H + (size_t)m_ * 1024 + 4 * lane + 256 * j); }   \
                else { const int s0_ = __builtin_amdgcn_readlane(sl0, r_), s1_ = __builtin_amdgcn_readlane(sl1, r_);             \
                    _Pragma("unroll") for (int j = 0; j < 4; ++j) { ny0##P[j] = *(const u32x2*)(A.OUTR + (size_t)s0_ * 1024 + 4 * lane + 256 * j); ny1##P[j] = *(const u32x2*)(A.OUTR + (size_t)s1_ * 1024 + 4 * lane + 256 * j); } } } } while (0)
#define THIN_TAKE(P) do { _Pragma("unroll") for (int j = 0; j < 4; ++j) { if (X32) x[j] = nxf##P[j]; else x[j] = (f32x4){bflo(nxh##P[j].x), bfhi(nxh##P[j].x), bflo(nxh##P[j].y), bfhi(nxh##P[j].y)}; cy0[j] = ny0##P[j]; cy1[j] = ny1##P[j]; } } while (0)
        auto thin_row = [&](const int rr, f32x4 (&x)[4], const u32x2 (&cy0)[4], const u32x2 (&cy1)[4]) __attribute__((always_inline)) {
            const int m = m0 + rr;
            if (HAS_Y) {
                f32x4 y[4];
                if (YMODE == 0) {
#pragma unroll
                    for (int j = 0; j < 4; ++j) y[j] = (f32x4){bflo(cy0[j].x), bfhi(cy0[j].x), bflo(cy0[j].y), bfhi(cy0[j].y)};
                } else {
                    const float g0 = __uint_as_float(__builtin_amdgcn_readlane(__float_as_uint(gg0), rr)), g1 = __uint_as_float(__builtin_amdgcn_readlane(__float_as_uint(gg1), rr));
#pragma unroll
                    for (int j = 0; j < 4; ++j) y[j] = (f32x4){bflo(cy0[j].x), bfhi(cy0[j].x), bflo(cy0[j].y), bfhi(cy0[j].y)} * g0 + (f32x4){bflo(cy1[j].x), bfhi(cy1[j].x), bflo(cy1[j].y), bfhi(cy1[j].y)} * g1;
                }
                float ss = 0.f;
#pragma unroll
                for (int j = 0; j < 4; ++j) ss += (y[j].x * y[j].x + y[j].y * y[j].y) + (y[j].z * y[j].z + y[j].w * y[j].w);
                const float rs = 1.0f / sqrtf(wave_sum(ss) * (1.0f / 1024.0f) + EPS);
#pragma unroll
                for (int j = 0; j < 4; ++j) { x[j] += y[j] * rs * a1[j];
                    if (XDST32) *(f32x4*)(A.xdst + (size_t)m * 1024 + 4 * lane + 256 * j) = x[j];
                    else { u32x2 w; w.x = cvtpk(x[j].x, x[j].y); w.y = cvtpk(x[j].z, x[j].w); *(u32x2*)(A.xdst16 + (size_t)m * 1024 + 4 * lane + 256 * j) = w; } }
            }
            if (HAS_NEXT) {
                float ss = 0.f;
#pragma unroll
                for (int j = 0; j < 4; ++j) ss += (x[j].x * x[j].x + x[j].y * x[j].y) + (x[j].z * x[j].z + x[j].w * x[j].w);
                const float rs = 1.0f / sqrtf(wave_sum(ss) * (1.0f / 1024.0f) + EPS);
                f32x4 hv[4];
#pragma unroll
                for (int j = 0; j < 4; ++j) { hv[j] = x[j] * rs * a2[j] + a3[j];
                    u32x2 w; w.x = cvtpk(hv[j].x, hv[j].y); w.y = cvtpk(hv[j].z, hv[j].w); *(u32x2*)(A.Hout + (size_t)m * 1024 + 4 * lane + 256 * j) = w; }
                if (ROUTER) {
                    float lg[8];
#pragma unroll
                    for (int e = 0; e < 8; ++e) { float s = 0.f;
#pragma unroll
                        for (int j = 0; j < 4; ++j) { const f32x4 wv = *(const LAS f32x4*)(Wt + e * 1024 + 4 * lane + 256 * j); s += (hv[j].x * wv.x + hv[j].y * wv.y) + (hv[j].z * wv.z + hv[j].w * wv.w); }
                        lg[e] = wave_sum(s) + brv[e]; }
                    int i1 = 0; float l1 = lg[0];
#pragma unroll
                    for (int e = 1; e < 8; ++e) if (lg[e] > l1) { l1 = lg[e]; i1 = e; }
                    int i2 = -1; float l2 = -__builtin_inff();
#pragma unroll
                    for (int e = 0; e < 8; ++e) if (e != i1 && lg[e] > l2) { l2 = lg[e]; i2 = e; }
                    const float g1 = 1.0f / (1.0f + __expf(l2 - l1)), g2 = 1.0f - g1;
                    if (lane == 0) { A.SEL[m] = i1 | (i2 << 8); A.GATEO[2 * m] = g1; A.GATEO[2 * m + 1] = g2; __hip_atomic_fetch_add(lcnt + i1, 1, __ATOMIC_RELAXED, __HIP_MEMORY_SCOPE_WORKGROUP); __hip_atomic_fetch_add(lcnt + i2, 1, __ATOMIC_RELAXED, __HIP_MEMORY_SCOPE_WORKGROUP); }
                }
            }
        };
        THIN_LOAD(A, 0); THIN_LOAD(B, 1);
        __builtin_amdgcn_sched_barrier(0);
#pragma unroll
        for (int j = 0; j < 4; ++j) {
            if (HAS_Y) a1[j] = q1[j] * q2[j]; else a1[j] = (f32x4){0.f, 0.f, 0.f, 0.f};
            if (HAS_NEXT) { a2[j] = q3[j] * (q4[j] + 1.0f); a3[j] = q5[j]; } else { a2[j] = (f32x4){0.f, 0.f, 0.f, 0.f}; a3[j] = a2[j]; } }
        if constexpr (THIN_DEEP) {
            THIN_LOAD(C, 2); THIN_LOAD(D, 3);
            for (int rr = 0; rr < 16; rr += 4) {
                f32x4 x[4]; u32x2 cy0[4], cy1[4];
                THIN_TAKE(A); THIN_LOAD(A, rr + 4); thin_row(rr, x, cy0, cy1);
                THIN_TAKE(B); THIN_LOAD(B, rr + 5); thin_row(rr + 1, x, cy0, cy1);
                THIN_TAKE(C); THIN_LOAD(C, rr + 6); thin_row(rr + 2, x, cy0, cy1);
                THIN_TAKE(D); THIN_LOAD(D, rr + 7); thin_row(rr + 3, x, cy0, cy1);
            }
        } else {
            for (int rr = 0; rr < 16; rr += 2) {
                f32x4 x[4]; u32x2 cy0[4], cy1[4];
                THIN_TAKE(A); THIN_LOAD(A, rr + 2); thin_row(rr, x, cy0, cy1);
                THIN_TAKE(B); THIN_LOAD(B, rr + 3); thin_row(rr + 1, x, cy0, cy1);
            }
        }
#undef THIN_TAKE
#undef THIN_LOAD
        if (A.router) { __syncthreads(); if (tid < 8) A.CCNT[(gwi >> 3) * 8 + tid] = lcnt[tid]; __syncthreads(); }
    }
}

__device__ __forceinline__ void moe_dispatch_phase(LAS unsigned char* lds, const int* CCNT, const int* SEL, int* SLOT, int* SEGT, int* RIDX, int vcu, int G) {
    const int tid = opaque_tid(), lane = tid & 63, wave = __builtin_amdgcn_readfirstlane(tid >> 6);
    LAS int* PRE = (LAS int*)lds;
    LAS int* TOT = PRE + 2048; LAS int* SEGR = TOT + 8; LAS int* W0C = SEGR + 16;
    {
        const int e = wave; int cv[4]; int s = 0;
#pragma unroll
        for (int i = 0; i < 4; ++i) { cv[i] = CCNT[(4 * lane + i) * 8 + e]; s += cv[i]; }
        int incl = s;
#pragma unroll
        for (int o = 1; o < 64; o <<= 1) { const int t = __shfl_up(incl, o); if (lane >= o) incl += t; }
        int run = incl - s;
#pragma unroll
        for (int i = 0; i < 4; ++i) { PRE[e * 256 + 4 * lane + i] = run; run += cv[i]; }
        if (lane == 63) TOT[e] = incl;
    }
    __syncthreads();
    if (tid == 0) { int r = 0; for (int e = 0; e < 8; ++e) { SEGR[e] = r; r += (TOT[e] + 255) & ~255; } SEGR[8] = r;
        if (blockIdx.x == 0) { for (int e = 0; e <= 8; ++e) SEGT[e] = SEGR[e] >> 8; } }
    __syncthreads();
    for (int e = vcu; e < 8; e += G) { const int p0 = SEGR[e] + TOT[e], p1 = SEGR[e + 1]; for (int u = p0 + tid; u < p1; u += NWAVES * 64) RIDX[u] = 0; }
    for (int chunk = vcu; chunk < 256; chunk += G) {
        const int m0 = chunk * 128;
        int e1 = 0, e2 = 0, r1 = 0, r2 = 0;
        if (wave < 2) {
            const int sel = SEL[m0 + tid]; e1 = sel & 255; e2 = (sel >> 8) & 255;
            const u64 lt = (lane == 0) ? 0ull : (~0ull >> (64 - lane));
#pragma unroll
            for (int e = 0; e < 8; ++e) { const bool f = (e1 == e) || (e2 == e); const u64 bal = __ballot(f); const int rk = __popcll(bal & lt);
                if (e == e1) r1 = rk; if (e == e2) r2 = rk; if (wave == 0 && lane == 0) W0C[e] = __popcll(bal); }
        }
        __syncthreads();
        if (wave < 2) {
            if (wave == 1) { r1 += W0C[e1]; r2 += W0C[e2]; }
            const int s1 = SEGR[e1] + PRE[e1 * 256 + chunk] + r1, s2 = SEGR[e2] + PRE[e2 * 256 + chunk] + r2;
            SLOT[2 * (m0 + tid)] = s1; SLOT[2 * (m0 + tid) + 1] = s2; RIDX[s1] = m0 + tid; RIDX[s2] = m0 + tid;
        }
        __syncthreads();
    }
}

__device__ __forceinline__ void mla_norm_phase(bf16_t* CIN, bf16_t* DST, const float* gq, const float* gkv, const float* cosm, const float* sinm, int vcu, int G) {
    const int tid = opaque_tid(), lane = tid & 63, wave = __builtin_amdgcn_readfirstlane(tid >> 6);
    float g[8];
#pragma unroll
    for (int i = 0; i < 8; ++i) g[i] = lane < 32 ? gq[8 * lane + i] : (lane < 48 ? gkv[8 * (lane & 15) + i] : 0.f);
    const int a8 = 8 * (lane & 3); const bool rl = lane >= 48 && lane < 56, upper = lane >= 52;
    const int stride = G * NWAVES;
    for (int mb = vcu * NWAVES + wave; mb < NTOK; mb += 4 * stride) {
        u32x4 w[4]; f32x4 c0[4], c1[4], s0[4], s1[4];
#pragma unroll
        for (int k = 0; k < 4; ++k) { const int m = mb + k * stride < NTOK ? mb + k * stride : NTOK - 1;
            w[k] = *(const u32x4*)(CIN + (size_t)m * 512 + 8 * lane);
            c0[k] = *(const f32x4*)(cosm + (size_t)m * 32 + a8); c1[k] = *(const f32x4*)(cosm + (size_t)m * 32 + a8 + 4);
            s0[k] = *(const f32x4*)(sinm + (size_t)m * 32 + a8); s1[k] = *(const f32x4*)(sinm + (size_t)m * 32 + a8 + 4); }
#pragma unroll
        for (int k = 0; k < 4; ++k) { const int m = mb + k * stride;
            const float v[8] = {bflo(w[k].x), bfhi(w[k].x), bflo(w[k].y), bfhi(w[k].y), bflo(w[k].z), bfhi(w[k].z), bflo(w[k].w), bfhi(w[k].w)};
            const float cc[8] = {c0[k].x, c0[k].y, c0[k].z, c0[k].w, c1[k].x, c1[k].y, c1[k].z, c1[k].w}, sv[8] = {s0[k].x, s0[k].y, s0[k].z, s0[k].w, s1[k].x, s1[k].y, s1[k].z, s1[k].w};
            float ss = 0.f;
#pragma unroll
            for (int i = 0; i < 8; ++i) ss += v[i] * v[i];
            const float sq = wave_sum(lane < 32 ? ss : 0.f), skv = wave_sum((lane >= 32 && lane < 48) ? ss : 0.f);
            const float rs = lane < 32 ? 1.0f / sqrtf(sq * (1.0f / 256.0f) + EPS) : 1.0f / sqrtf(skv * (1.0f / 128.0f) + EPS);
            float o[8];
#pragma unroll
            for (int i = 0; i < 8; ++i) { const float pv = __shfl_xor(v[i], 4);
                const float r = upper ? (v[i] * cc[i] + pv * sv[i]) : (v[i] * cc[i] - pv * sv[i]);
                o[i] = lane < 48 ? v[i] * rs * g[i] : (rl ? r : 0.f); }
            u32x4 ow; ow.x = cvtpk(o[0], o[1]); ow.y = cvtpk(o[2], o[3]); ow.z = cvtpk(o[4], o[5]); ow.w = cvtpk(o[6], o[7]);
            if (m < NTOK) *(u32x4*)(DST + (size_t)m * 512 + 8 * lane) = ow; }
    }
}

__device__ __forceinline__ void dsa_rope_phase(bf16_t* QKVI, bf16_t* DSTB, bf16_t* KI, const float* gk, const float* cosa, const float* sina, const float* cosi, const float* sini, int vcu, int G) {
    const int tid = opaque_tid(), lane = tid & 63, wave = __builtin_amdgcn_readfirstlane(tid >> 6);
    const float gkl = gk[lane];
    const int stride = G * NWAVES;
    const int kl = lane & 31;
    for (int mb = vcu * NWAVES + wave; mb < NTOK; mb += 4 * stride) {
        float ca[4], sa[4], ci[4], si[4]; bf16_t qa0[4][2], qa1[4][2], ka0[4], ka1[4], ia0[4], ia1[4], kx[4];
#pragma unroll
        for (int k = 0; k < 4; ++k) { const int m = mb + k * stride < NTOK ? mb + k * stride : NTOK - 1; const bf16_t* P = QKVI + (size_t)m * DSAW;
            ca[k] = cosa[(size_t)m * 16 + (lane & 15)]; sa[k] = sina[(size_t)m * 16 + (lane & 15)]; ci[k] = cosi[(size_t)m * 8 + (lane & 7)]; si[k] = sini[(size_t)m * 8 + (lane & 7)];
#pragma unroll
            for (int t = 0; t < 2; ++t) { const int p_ = lane + 64 * t, hd = p_ >> 4, j = p_ & 15; qa0[k][t] = P[hd * 128 + j]; qa1[k][t] = P[hd * 128 + j + 16]; }
            { const int hd = kl >> 4, j = kl & 15; ka0[k] = P[1024 + hd * 128 + j]; ka1[k] = P[1024 + hd * 128 + j + 16]; }
            { const int hd = lane >> 3, j = lane & 7; ia0[k] = P[1536 + hd * 64 + j]; ia1[k] = P[1536 + hd * 64 + j + 8]; }
            kx[k] = P[2048 + lane]; }
#pragma unroll
        for (int k = 0; k < 4; ++k) { const int m = mb + k * stride; if (m >= NTOK) continue;
            bf16_t* Pd = DSTB + (size_t)m * DSAW;
#pragma unroll
            for (int t = 0; t < 2; ++t) { const int p_ = lane + 64 * t, hd = p_ >> 4, j = p_ & 15; bf16_t* d = Pd + hd * 128 + j;
                const float x1 = bf2f(qa0[k][t]), x2 = bf2f(qa1[k][t]); const unsigned w = cvtpk(x1 * ca[k] - x2 * sa[k], x2 * ca[k] + x1 * sa[k]); d[0] = (bf16_t)(w & 0xffff); d[16] = (bf16_t)(w >> 16); }
            if (lane < 32) { const int hd = lane >> 4, j = lane & 15; bf16_t* d = Pd + 1024 + hd * 128 + j;
                const float x1 = bf2f(ka0[k]), x2 = bf2f(ka1[k]); const unsigned w = cvtpk(x1 * ca[k] - x2 * sa[k], x2 * ca[k] + x1 * sa[k]); d[0] = (bf16_t)(w & 0xffff); d[16] = (bf16_t)(w >> 16); }
            { const int hd = lane >> 3, j = lane & 7; bf16_t* d = Pd + 1536 + hd * 64 + j;
                const float x1 = bf2f(ia0[k]), x2 = bf2f(ia1[k]); const unsigned w = cvtpk(x1 * ci[k] - x2 * si[k], x2 * ci[k] + x1 * si[k]); d[0] = (bf16_t)(w & 0xffff); d[8] = (bf16_t)(w >> 16); }
            { const float x = bf2f(kx[k]); const float ss = wave_sum(x * x);
                const float y = x * (1.0f / sqrtf(ss * (1.0f / 64.0f) + EPS)) * gkl;
                const float yp = __shfl_xor(y, 8);
                float o = y;
                if (lane < 8) o = y * ci[k] - yp * si[k]; else if (lane < 16) o = y * ci[k] + yp * si[k];
                const unsigned w = cvtpk(o, 0.f); Pd[2048 + lane] = (bf16_t)(w & 0xffff); KI[(size_t)m * 64 + lane] = (bf16_t)(w & 0xffff); }
        }
    }
}

constexpr int D3_H_OFF = RING_BYTES + 512, D3_HQ = 320;
static_assert(D3_H_OFF + 8 * D3_HQ * 4 <= LDS_BYTES, "select histograms");
__device__ __forceinline__ void wlane2(unsigned lo, unsigned hi, int ln, unsigned& vlo, unsigned& vhi) {
    ln = __builtin_amdgcn_readfirstlane(ln); lo = __builtin_amdgcn_readfirstlane(lo); hi = __builtin_amdgcn_readfirstlane(hi); unsigned keep;
    asm volatile("s_mov_b32 %2, m0\n\ts_mov_b32 m0, %5\n\ts_nop 3\n\tv_writelane_b32 %0, %3, m0\n\tv_writelane_b32 %1, %4, m0\n\ts_mov_b32 m0, %2" : "+v"(vlo), "+v"(vhi), "=&s"(keep) : "s"(lo), "s"(hi), "s"(ln));
}
__device__ __forceinline__ unsigned ord16(float f) { const _Float16 hf = (_Float16)(f + 0.0f); const unsigned b = (unsigned)__builtin_bit_cast(unsigned short, hf);
    const unsigned sgn = (unsigned)((int)(b << 16) >> 31);    return (b ^ (sgn | 0x8000u)) & 0xFFFFu; }
__device__ __forceinline__ void find_bin(const LAS unsigned* Hq, int lane, int target, int& bin, int& above, int& cnt) {
    const u32x4 c = *(const LAS u32x4*)(Hq + 4 * lane);
    const int ls = (int)(c.x + c.y + c.z + c.w); int S = ls;
#pragma unroll
    for (int o = 1; o < 64; o <<= 1) { const int v = __shfl_down(S, o); if (lane + o < 64) S += v; }
    const u64 m = __ballot(S >= target);
    const int L = m ? 63 - __builtin_clzll(m) : 0;
    const int ab = __builtin_amdgcn_readlane(S - ls, L);
    const int d0 = __builtin_amdgcn_readlane((int)c.x, L), d1 = __builtin_amdgcn_readlane((int)c.y, L), d2 = __builtin_amdgcn_readlane((int)c.z, L), d3 = __builtin_amdgcn_readlane((int)c.w, L);
    int cum = ab;
    if (cum + d3 >= target) { bin = 4 * L + 3; above = cum; cnt = d3; }
    else { cum += d3; if (cum + d2 >= target) { bin = 4 * L + 2; above = cum; cnt = d2; }
        else { cum += d2; if (cum + d1 >= target) { bin = 4 * L + 1; above = cum; cnt = d1; } else { cum += d1; bin = 4 * L; above = cum; cnt = d0; } } }
}
__device__ __forceinline__ void dsa_select_phase(LAS unsigned char* lds, const bf16_t* QKVI, const bf16_t* KI, u64* MASK, int vcu, int G) {
    const int tid = opaque_tid(), lane = tid & 63, wave = __builtin_amdgcn_readfirstlane(tid >> 6);
    LAS unsigned short* SC = (LAS unsigned short*)lds;
    LAS unsigned* HB = (LAS unsigned*)(lds + D3_H_OFF);
    const int r32 = lane & 31, hi = lane >> 5;
    constexpr int NU = NTOK / 8;
    for (int rnd = 0; rnd * G < NU; ++rnd) {
        int b, grp;
        if (G == 256) { const int x = vcu >> 5, w = ((x >> 2) << 5) | (vcu & 31); if (rnd >= 16) break; b = x & 3; grp = 1023 - (rnd * 64 + ((rnd & 1) ? 63 - w : w)); }
        else { const int k = rnd * G + ((rnd & 1) ? (G - 1 - vcu) : vcu); if (k >= NU) continue; b = k & 3; grp = 1023 - (k >> 2); }
        const int t0 = grp * 8; const size_t tok0 = (size_t)b * SEQ;
        const int t = t0 + wave;
        if (t0 < 256) {
            if (lane < 4) { const int d = t - 64 * lane; const u64 w = d < 0 ? 0ull : (d >= 63 ? ~0ull : ((1ull << (d + 1)) - 1ull)); MASK[((size_t)b * 128 + lane) * SEQ + t] = w; }
            continue;
        }
        for (int rep1_ = 0; rep1_ < (((DUP_MASK) & 1024) ? 2 : 1); ++rep1_) {
        if (rep1_) __syncthreads();
        for (int u = tid; u < 8 * D3_HQ; u += 512) HB[u] = 0u;
        __syncthreads();
        {
            bf16x8 qa[2][4]; bf16x8 wq[2][2];
#pragma unroll
            for (int blk = 0; blk < 2; ++blk) { const bf16_t* qp = QKVI + (tok0 + t0 + 4 * blk + (r32 >> 3)) * DSAW + 1536 + (r32 & 7) * 64 + hi * 8;
#pragma unroll
                for (int ks = 0; ks < 4; ++ks) qa[blk][ks] = *(const bf16x8*)(qp + ks * 16); }
            { u32x2 ww = (u32x2){0u, 0u};
              if (r32 < 8) ww = *(const u32x2*)(QKVI + (tok0 + t0 + r32) * DSAW + 2112 + 4 * hi);
#pragma unroll
              for (int blk = 0; blk < 2; ++blk)
#pragma unroll
                  for (int kst = 0; kst < 2; ++kst) { const bool mt = r32 < 8 && (r32 >> 2) == blk && ((r32 & 3) >> 1) == kst; const bool hiq = (r32 & 1) != 0;
                      u32x4 f; f.x = (mt && !hiq) ? ww.x : 0u; f.y = (mt && !hiq) ? ww.y : 0u; f.z = (mt && hiq) ? ww.x : 0u; f.w = (mt && hiq) ? ww.y : 0u;
                      wq[blk][kst] = *reinterpret_cast<bf16x8*>(&f); } }
            const int nk = t0 + 8, ntile = ((nk + 511) & ~511) >> 5, nreal = (nk + 31) >> 5;
            const bf16_t* kbase = KI + tok0 * 64 + hi * 8;
            bf16x8 kb[4], kn[4];
#define D3_LOADK(dst, tl) do { if ((tl) < nreal) { _Pragma("unroll") for (int ks = 0; ks < 4; ++ks) dst[ks] = *(const bf16x8*)(kbase + (size_t)((tl) * 32 + r32) * 64 + ks * 16); } } while (0)
#define D3_TILE(KB, tl, UNC) do { const int tl_ = (tl); const int s = tl_ * 32 + r32;                                                 \
                if ((UNC) || tl_ < nreal) {                                                                                      \
                    f32x16 acc0 = {}, acc1 = {};                                                                                 \
                    _Pragma("unroll") for (int ks = 0; ks < 4; ++ks) { acc0 = __builtin_amdgcn_mfma_f32_32x32x16_bf16(qa[0][ks], KB[ks], acc0, 0, 0, 0); acc1 = __builtin_amdgcn_mfma_f32_32x32x16_bf16(qa[1][ks], KB[ks], acc1, 0, 0, 0); } \
                    if (UNC) { _Pragma("unroll") for (int ks = 0; ks < 4; ++ks) KB[ks] = *(const bf16x8*)(kbase + (size_t)((tl_ + 16) * 32 + r32) * 64 + ks * 16); } else D3_LOADK(KB, tl_ + 16); \
                    f32x16 c2 = {};                                                                                              \
                    _Pragma("unroll") for (int kst = 0; kst < 2; ++kst) {                                                        \
                        u32x4 b0_, b1_;                                                                                          \
                        b0_.x = cvtpk_c(acc0[8 * kst + 0], acc0[8 * kst + 1]); b0_.y = cvtpk_c(acc0[8 * kst + 2], acc0[8 * kst + 3]); b0_.z = cvtpk_c(acc0[8 * kst + 4], acc0[8 * kst + 5]); b0_.w = cvtpk_c(acc0[8 * kst + 6], acc0[8 * kst + 7]); \
                        b1_.x = cvtpk_c(acc1[8 * kst + 0], acc1[8 * kst + 1]); b1_.y = cvtpk_c(acc1[8 * kst + 2], acc1[8 * kst + 3]); b1_.z = cvtpk_c(acc1[8 * kst + 4], acc1[8 * kst + 5]); b1_.w = cvtpk_c(acc1[8 * kst + 6], acc1[8 * kst + 7]); \
                        const bf16x8 r0_ = __builtin_elementwise_max(*reinterpret_cast<bf16x8*>(&b0_), (bf16x8)0), r1_ = __builtin_elementwise_max(*reinterpret_cast<bf16x8*>(&b1_), (bf16x8)0);     \
                        c2 = __builtin_amdgcn_mfma_f32_32x32x16_bf16(wq[0][kst], r0_, c2, 0, 0, 0); c2 = __builtin_amdgcn_mfma_f32_32x32x16_bf16(wq[1][kst], r1_, c2, 0, 0, 0); } \
                    const bool diag = !(UNC) && tl_ * 32 + 31 > t0;     \
                    _Pragma("unroll") for (int i = 0; i < 4; ++i) { const int q = 4 * hi + i; unsigned key = ord16(c2[i]);       \
                        if (diag && s > t0 + q) key = 0u;                                                                        \
                        SC[q * 8192 + s] = (unsigned short)key;                                                                  \
                        if ((UNC) || key) __hip_atomic_fetch_add(HB + q * D3_HQ + (key >> 8), 1u, __ATOMIC_RELAXED, __HIP_MEMORY_SCOPE_WORKGROUP); } \
                } else {                                                                                                         \
                    _Pragma("unroll") for (int i = 0; i < 4; ++i) SC[(4 * hi + i) * 8192 + s] = 0;                            \
                } } while (0)
            int tile = wave;
            D3_LOADK(kb, tile); D3_LOADK(kn, tile + 8);
            for (; tile + 24 < nreal; tile += 16) {
                D3_TILE(kb, tile, true);
                D3_TILE(kn, tile + 8, true);
            }
            for (; tile < ntile; tile += 16) {
                D3_TILE(kb, tile, false);
                if (tile + 8 < ntile) D3_TILE(kn, tile + 8, false);
            }
#undef D3_TILE
#undef D3_LOADK
        }
        }
        __syncthreads();
        {
            LAS unsigned* Hq = HB + wave * D3_HQ;
            int b1, ab1, c1; find_bin(Hq, lane, 256, b1, ab1, c1);
            const int k2 = 256 - ab1;
#pragma unroll
            for (int i = 0; i < 5; ++i) Hq[lane + 64 * i] = 0u;
            const int nch = (t + 512) >> 9;
            for (int i = 0; i < nch; ++i) {
                const u32x4 kx = *(const LAS u32x4*)(SC + wave * 8192 + (i * 64 + lane) * 8);
#pragma unroll
                for (int w = 0; w < 4; ++w) { const unsigned x = kx[w];
                    const unsigned lo = x & 0xffffu, hh = x >> 16;
                    const unsigned binl = ((lo >> 8) == (unsigned)b1) ? (lo & 255u) : (256u + lane), binh = ((hh >> 8) == (unsigned)b1) ? (hh & 255u) : (256u + lane);
                    __hip_atomic_fetch_add(Hq + binl, 1u, __ATOMIC_RELAXED, __HIP_MEMORY_SCOPE_WORKGROUP); __hip_atomic_fetch_add(Hq + binh, 1u, __ATOMIC_RELAXED, __HIP_MEMORY_SCOPE_WORKGROUP); }
            }
            int b2, ab2, c2; find_bin(Hq, lane, k2, b2, ab2, c2);
            const unsigned tau = ((unsigned)b1 << 8) | (unsigned)b2;
            int need = k2 - ab2;
            const bool ties = need != c2;
            const int jmax = (t | 255) >> 6;
            unsigned w0l = 0u, w0h = 0u, w1l = 0u, w1h = 0u;
            const LAS unsigned short* Sq = SC + wave * 8192 + lane;
            if (!ties) {
                for (int j = 0; j <= jmax; j += 4) {
                    unsigned key[4];
#pragma unroll
                    for (int u = 0; u < 4; ++u) key[u] = Sq[(j + u) * 64];
                    if (j < 64) {
#pragma unroll
                        for (int u = 0; u < 4; ++u) { const u64 wd = __ballot(key[u] >= tau); wlane2((unsigned)wd, (unsigned)(wd >> 32), j + u, w0l, w0h); } }
                    else {
#pragma unroll
                        for (int u = 0; u < 4; ++u) { const u64 wd = __ballot(key[u] >= tau); wlane2((unsigned)wd, (unsigned)(wd >> 32), j + u - 64, w1l, w1h); } }
                }
            } else {
                for (int j = 0; j <= jmax; ++j) {
                    const unsigned key = Sq[j * 64];
                    const u64 bg = __ballot(key > tau), be = __ballot(key == tau);
                    u64 sel = be; const int pe = __popcll(be);
                    if (pe > need) { u64 rem = be; sel = 0ull; for (int q = 0; q < need; ++q) { const u64 low = rem & (0ull - rem); sel |= low; rem ^= low; } }
                    need -= __popcll(sel);
                    const u64 wd = bg | sel;
                    if (j < 64) { wlane2((unsigned)wd, (unsigned)(wd >> 32), j, w0l, w0h); }
                    else { wlane2((unsigned)wd, (unsigned)(wd >> 32), j - 64, w1l, w1h); }
                }
            }
            if (lane <= jmax) MASK[((size_t)b * 128 + lane) * SEQ + t] = ((u64)w0h << 32) | w0l;
            if (64 + lane <= jmax) MASK[((size_t)b * 128 + 64 + lane) * SEQ + t] = ((u64)w1h << 32) | w1l;
        }
        LDS_BARRIER();
    }
}
#ifndef MK_SPLIT
#define MK_SPLIT 0
#endif
#ifndef DUP_MASK
#define DUP_MASK 0
#endif
#define THIN_RUN(A, ...) do { if ((DUP_MASK) & 128) { ThinArgs D_ = (A); if (D_.xdst) D_.xdst = (float*)P_BIG; if (D_.xdst16) D_.xdst16 = P_BIG; D_.Hout = P_BIG + 64 * 1024 * 1024; thin_phase<__VA_ARGS__>(lds, D_, vcu, G); } thin_phase<__VA_ARGS__>(lds, (A), vcu, G); } while (0)
#define REP(bit) for (int rep_ = 0; rep_ < (((DUP_MASK) & (bit)) ? 2 : 1); ++rep_)
constexpr int CW_BAR = 4096;
constexpr int MAX_BAR_REGIONS = 48;
constexpr int CW_AFLAG = 64;
#ifndef FORCE_FALLBACK
#define FORCE_FALLBACK 0
#endif
static_assert((CW_BAR + MAX_BAR_REGIONS * XCD_BAR_WORDS) * 4 <= (int)CTL_ZERO_BYTES && (CW_BAR + XCD_BAR_WORDS) * 4 <= 32768, "barrier regions inside the memset");

struct Args { const float* in[23]; float* out; unsigned char* ws; int ph_lo, ph_hi, li, pad; };

__global__ void __launch_bounds__(NWAVES * 64, 2) trunk_fwd(Args args) {
    extern __shared__ __attribute__((aligned(16))) unsigned char lds_raw[];
    LAS unsigned char* lds = (LAS unsigned char*)lds_raw;
    volatile LAS unsigned* MISC = (volatile LAS unsigned*)(lds + MISC_OFF);
    const int tid = threadIdx.x, lane = tid & 63, wave = __builtin_amdgcn_readfirstlane(tid >> 6);
    const int G = gridDim.x; const int bx = blockIdx.x; const int vcu = (G % 8 == 0) ? (bx % 8) * (G / 8) + bx / 8 : bx;
    unsigned* ctl = (unsigned*)(args.ws + WS_CTL);
    for (int u = tid; u < (LDS_BYTES - LDSCTL_OFF) / 4; u += NWAVES * 64) ((LAS unsigned*)(lds + LDSCTL_OFF))[u] = 0u;
    __syncthreads();
    const int lo = args.ph_lo, hi = args.ph_hi;
    XcdBarrier bar; bar.bar = ctl + CW_BAR + args.li * XCD_BAR_WORDS; bar.x = 0; bar.st = nullptr;
    if (hi - lo > 1) bar = xcd_barrier_post(ctl + CW_BAR + args.li * XCD_BAR_WORDS, MISC + 8);
    int ph = 0; const int li_ = args.li;
#define IN_PH() (lo <= ph && ph < hi)
#define SEAM() do { if (IN_PH() && ph + 1 < hi) { XcdBarrier b_ = bar; { unsigned* bp_ = bar.bar; asm volatile("" : "+s"(bp_)); b_.bar = bp_; } xcd_barrier(b_); if ((DUP_MASK) & 512) xcd_barrier(b_); } ++ph; } while (0)

#define WSP (args.ws)
#define INP(i) (args.in[i])
#define P_ws WSP
#define P_out (args.out)
#define P_MOD ((float*)(WSP + WS_MOD))
#define P_H ((bf16_t*)(args.out))
#define P_X16 ((bf16_t*)(WSP + WS_H))
#define P_BIG ((bf16_t*)(WSP + WS_BIG))
#define P_BIG2 ((bf16_t*)(WSP + WS_BIG2))
#define P_O ((bf16_t*)(WSP + WS_O))
#define P_CIN ((bf16_t*)(WSP + BIG_MLA_CIN))
#define P_MASK ((u64*)(WSP + BIG_DSA_MASK))
#define P_KIX ((bf16_t*)(WSP + BIG_DSA_MASK + 32 * MiB))
#define P_SEL ((int*)(WSP + MOE_SEL))
#define P_GATE ((float*)(WSP + MOE_GATE))
#define P_SLOT ((int*)(WSP + MOE_SLOT))
#define P_CCNT ((int*)(WSP + MOE_CCNT))
#define P_SEGT ((int*)(WSP + MOE_SEG))
#define P_RIDX ((int*)(WSP + MOE_RIDX))
#define P_normg INP(5)

    if (IN_PH()) REP(64) prologue_phase(lds, args.in, (const int*)args.in[2], args.ws, vcu, G);
    SEAM();
    if (IN_PH()) { ThinArgs A{}; A.xsrc = INP(0); A.H = P_H; A.has_y = 0; A.ymode = 0; A.has_next = 1; A.router = 0;
        A.nsc = P_MOD + 1024; A.nsh = P_MOD; A.gpre = P_normg; A.Hout = P_H; THIN_RUN(A, true, false, 0, true, false, false); }
    SEAM();

    for (int layer = 0; layer < DEPTH; ++layer) {
        const int kind = layer % 3, f = layer >> 1; const bool moe = (layer & 1) != 0;
        const float* MODl = P_MOD + (size_t)layer * 4 * 6144;
        if (IN_PH()) REP(1) {
            const bf16_t* Bt = kind == 0 ? (const bf16_t*)(P_ws + W_SBIN) + (size_t)(layer == 3 ? 1 : 0) * SBW * DM : (kind == 1 ? (const bf16_t*)(P_ws + W_MLAIN) : (const bf16_t*)(P_ws + W_DSAIN));
            const int N = kind == 0 ? SBW : (kind == 1 ? MLAW : DSAW);
            bf16_t* outp = kind == 1 ? P_CIN : P_BIG;
            pg8::Gemm g{P_H, Bt, DM, DM}; pg8::StaticOrder S; S.init(NTOK, N, G, bx); pg8::EpiStore E{outp, N};
            pg8::gemm_phase<pg8::EpiStore, pg8::StaticOrder, true>(lds + RING_OFF, g, S, E);
        }
        SEAM();
        if (kind == 1) {
            if (IN_PH()) { if ((DUP_MASK) & 256) mla_norm_phase(P_CIN, P_BIG2, INP(9), INP(11), (const float*)(P_ws + RP_COSM), (const float*)(P_ws + RP_SINM), vcu, G);
                mla_norm_phase(P_CIN, P_CIN, INP(9), INP(11), (const float*)(P_ws + RP_COSM), (const float*)(P_ws + RP_SINM), vcu, G); }
            SEAM();
            if (IN_PH()) REP(1) {
                { pg8::Gemm g{P_CIN, (const bf16_t*)(P_ws + W_MLAQ), MLAW, 256}; pg8::StaticOrder S; S.init(NTOK, 1536, G, bx); pg8::EpiStore E{P_BIG, 1536};
                  pg8::gemm_phase<pg8::EpiStore, pg8::StaticOrder, true>(lds + RING_OFF, g, S, E); }
                { int kkv = 128; asm volatile("" : "+s"(kkv));
                  pg8::Gemm g{P_CIN + 256, (const bf16_t*)(P_ws + W_MLAKV), MLAW, kkv}; pg8::StaticOrder S; S.init(NTOK, 2048, G, bx); pg8::EpiStore E{P_BIG2, 2048};
                  pg8::gemm_phase<pg8::EpiStore, pg8::StaticOrder, true>(lds + RING_OFF, g, S, E); }
            }
            SEAM();
        }
        if (kind == 2) {
            if (IN_PH()) { if ((DUP_MASK) & 256) dsa_rope_phase(P_BIG, P_BIG2, P_KIX, INP(15), (const float*)(P_ws + RP_COSA), (const float*)(P_ws + RP_SINA), (const float*)(P_ws + RP_COSI), (const float*)(P_ws + RP_SINI), vcu, G);
                dsa_rope_phase(P_BIG, P_BIG, P_KIX, INP(15), (const float*)(P_ws + RP_COSA), (const float*)(P_ws + RP_SINA), (const float*)(P_ws + RP_COSI), (const float*)(P_ws + RP_SINI), vcu, G); }
            SEAM();
            if (IN_PH()) REP(32) dsa_select_phase(lds, P_BIG, P_KIX, P_MASK, vcu, G);
            SEAM();
        }
        if (IN_PH()) {
            fa::AttnArgs A{};
            A.O = P_O;
            if (kind == 0) { A.Q = P_BIG; A.qpitch = SBW; A.qhs = 128; A.K = P_BIG + 1024; A.kpitch = SBW; A.khs = 128; A.V = P_BIG + 2048; A.vpitch = SBW; A.vhs = 128; A.kvdiv = 1;
                REP(4) fa::attn_phase<0>(lds, A, vcu, G); }
            else if (kind == 1) { A.Q = P_BIG; A.qpitch = 1536; A.qhs = 192; A.K = P_BIG2; A.kpitch = 2048; A.khs = 256; A.V = P_BIG2 + 128; A.vpitch = 2048; A.vhs = 256; A.kvdiv = 1;
                A.KR = P_CIN + 384; A.krpitch = MLAW; A.cosm = (const float*)(P_ws + RP_COSM); A.sinm = (const float*)(P_ws + RP_SINM);
                A.flag = ctl + CW_AFLAG + layer; REP(8) fa::attn_phase<1, true>(lds, A, vcu, G); }
            else { A.Q = P_BIG; A.qpitch = DSAW; A.qhs = 128; A.K = P_BIG + 1024; A.kpitch = DSAW; A.khs = 128; A.V = P_BIG + 1280; A.vpitch = DSAW; A.vhs = 128; A.kvdiv = 4; A.mask = P_MASK;
                A.flag = ctl + CW_AFLAG + layer; REP(16) fa::attn_phase<2, true>(lds, A, vcu, G); }
        }
        SEAM();
        if (IN_PH() && kind != 0) {
            if ((FORCE_FALLBACK) || __hip_atomic_load(ctl + CW_AFLAG + layer, __ATOMIC_RELAXED, __HIP_MEMORY_SCOPE_AGENT) != 0u) {
                if (kind == 1) { fa::AttnArgs A{}; A.O = P_O; A.Q = P_BIG; A.qpitch = 1536; A.qhs = 192; A.K = P_BIG2; A.kpitch = 2048; A.khs = 256; A.V = P_BIG2 + 128; A.vpitch = 2048; A.vhs = 256; A.kvdiv = 1;
                    A.KR = P_CIN + 384; A.krpitch = MLAW; A.cosm = (const float*)(P_ws + RP_COSM); A.sinm = (const float*)(P_ws + RP_SINM);
                    fa::attn_phase<1, false>(lds, A, vcu, G); }
                else { fa::AttnArgs A{}; A.O = P_O; A.Q = P_BIG; A.qpitch = DSAW; A.qhs = 128; A.K = P_BIG + 1024; A.kpitch = DSAW; A.khs = 128; A.V = P_BIG + 1280; A.vpitch = DSAW; A.vhs = 128; A.kvdiv = 4; A.mask = P_MASK;
                    fa::attn_phase<2, false>(lds, A, vcu, G); }
                { XcdBarrier b_ = bar; { unsigned* bp_ = bar.bar; asm volatile("" : "+s"(bp_)); b_.bar = bp_; } xcd_barrier(b_); } } }
        if (IN_PH()) REP(1) {
            const bf16_t* Bt = kind == 0 ? (const bf16_t*)(P_ws + W_SBOUT) + (size_t)(layer == 3 ? 1 : 0) * DM * DM : (kind == 1 ? (const bf16_t*)(P_ws + W_MLAOUT) : (const bf16_t*)(P_ws + W_DSAOUT));
            pg8::Gemm g{P_O, Bt, DM, DM}; pg8::StaticOrder S; S.init(NTOK, DM, G, bx); pg8::EpiStore E{P_H, DM};
            pg8::gemm_phase<pg8::EpiStore, pg8::StaticOrder, true>(lds + RING_OFF, g, S, E);
        }
        SEAM();
        if (IN_PH()) { ThinArgs A{}; if (layer == 0) A.xsrc = INP(0); else A.xsrc16 = P_X16; A.xdst16 = P_X16; A.H = P_H; A.has_y = 1; A.ymode = 0; A.has_next = 1; A.router = moe ? 1 : 0;
            A.gate = MODl + 2048; A.gpost = P_normg + (layer * 4 + 1) * 1024; A.nsc = MODl + 4096; A.nsh = MODl + 3072; A.gpre = P_normg + (layer * 4 + 2) * 1024;
            A.wr = INP(19) + (size_t)f * 8192; A.br = INP(20) + f * 8; A.SEL = P_SEL; A.GATEO = P_GATE; A.CCNT = P_CCNT;
            A.Hout = P_H;
            if (layer == 0) THIN_RUN(A, true, true, 0, true, false, false); else if (moe) THIN_RUN(A, false, true, 0, true, true, false); else THIN_RUN(A, false, true, 0, true, false, false); }
        SEAM();
        if (moe) {
            if (IN_PH()) REP(256) moe_dispatch_phase(lds, P_CCNT, P_SEL, P_SLOT, P_SEGT, P_RIDX, vcu, G);
            SEAM();
        }
        if (IN_PH()) REP(2) {
            pg8::GroupOrder S; S.G = G; S.c = bx;
            if (moe) { S.nN = 11;
#pragma unroll
                for (int e = 0; e < 9; ++e) S.st[e] = P_SEGT[e];
                S.nM = S.st[8];
                pg8::Gemm g{P_H, (const bf16_t*)(P_ws + W_MOEGU) + (size_t)f * NEXP * 2 * DFFE * DM, DM, DM}; pg8::EpiSwiGLU E{P_BIG, DFFE};
                pg8::gemm_phase<pg8::EpiSwiGLU, pg8::GroupOrder, true, true>(lds + RING_OFF, g, S, E, P_RIDX); }
            else { S.nN = 22; S.nM = NTOK / 256; S.st[0] = 0;
#pragma unroll
                for (int e = 1; e < 9; ++e) S.st[e] = NTOK / 256;
                pg8::Gemm g{P_H, (const bf16_t*)(P_ws + W_FFNGU) + (size_t)f * 2 * DFF * DM, DM, DM}; pg8::EpiSwiGLU E{P_BIG, DFF};
                pg8::gemm_phase<pg8::EpiSwiGLU, pg8::GroupOrder, true>(lds + RING_OFF, g, S, E); }
        }
        SEAM();
        if (IN_PH()) REP(2) {
            pg8::GroupOrder S; S.G = G; S.c = bx; S.nN = 4;
            if (moe) {
#pragma unroll
                for (int e = 0; e < 9; ++e) S.st[e] = P_SEGT[e];
                S.nM = S.st[8];
                pg8::Gemm g{P_BIG, (const bf16_t*)(P_ws + W_MOEDN) + (size_t)f * NEXP * DM * DFFE, DFFE, DFFE}; pg8::EpiStore E{P_BIG2, DM};
                pg8::gemm_phase<pg8::EpiStore, pg8::GroupOrder, true>(lds + RING_OFF, g, S, E); }
            else { S.nM = NTOK / 256; S.st[0] = 0;
#pragma unroll
                for (int e = 1; e < 9; ++e) S.st[e] = NTOK / 256;
                pg8::Gemm g{P_BIG, (const bf16_t*)(P_ws + W_FFNDN) + (size_t)f * DM * DFF, DFF, DFF}; pg8::EpiStore E{P_H, DM};
                pg8::gemm_phase<pg8::EpiStore, pg8::GroupOrder, true>(lds + RING_OFF, g, S, E); }
        }
        SEAM();
        if (IN_PH()) { ThinArgs A{}; A.xsrc16 = P_X16; if (layer == DEPTH - 1) A.xdst = P_out; else A.xdst16 = P_X16; A.H = P_H; A.has_y = 1; A.ymode = moe ? 1 : 0; A.has_next = layer < DEPTH - 1 ? 1 : 0; A.router = 0;
            A.gate = MODl + 5120; A.gpost = P_normg + (layer * 4 + 3) * 1024;
            if (layer < DEPTH - 1) { const float* MODn = MODl + 4 * 6144; A.nsc = MODn + 1024; A.nsh = MODn; A.gpre = P_normg + ((layer + 1) * 4) * 1024; }
            A.OUTR = P_BIG2; A.SLOT = P_SLOT; A.GATEV = P_GATE; A.Hout = P_H;
            if (!moe) THIN_RUN(A, false, true, 0, true, false, false); else if (layer < DEPTH - 1) THIN_RUN(A, false, true, 1, true, false, false); else THIN_RUN(A, false, true, 1, false, false, true); }
        SEAM();
    }
#undef IN_PH
#undef SEAM
#undef P_ws
#undef WSP
#undef INP
#undef P_out
#undef P_MOD
#undef P_H
#undef P_X16
#undef P_BIG
#undef P_BIG2
#undef P_O
#undef P_CIN
#undef P_MASK
#undef P_KIX
#undef P_SEL
#undef P_GATE
#undef P_SLOT
#undef P_CCNT
#undef P_SEGT
#undef P_RIDX
#undef P_normg
}

constexpr int N_PHASES = 2 + 7 + 10 + 9 + 8;
extern "C" void kernel_launch(void* const* d_in, const int* in_sizes, int n_in, void* d_out, int out_size, void* d_ws, size_t ws_size, hipStream_t stream) {
    static int grid = 0;
    if (grid == 0) {
        if (n_in != 23 || in_sizes[0] != NTOK * DM || out_size != NTOK * DM || ws_size < WS_END) { fprintf(stderr, "kernel_launch: unexpected shapes / workspace (n_in %d, ws %zu, need %zu)\n", n_in, ws_size, (size_t)WS_END); grid = -1; return; }
        int dev = 0, cus = 0, per_cu = 0;
        if (hipGetDevice(&dev) != hipSuccess || hipDeviceGetAttribute(&cus, hipDeviceAttributeMultiprocessorCount, dev) != hipSuccess) { grid = -1; return; }
        if (hipFuncSetAttribute((const void*)trunk_fwd, hipFuncAttributeMaxDynamicSharedMemorySize, LDS_BYTES) != hipSuccess) { grid = -1; return; }
        if (hipOccupancyMaxActiveBlocksPerMultiprocessor(&per_cu, (const void*)trunk_fwd, NWAVES * 64, LDS_BYTES) != hipSuccess || per_cu < 1) { (void)hipGetLastError(); fprintf(stderr, "kernel_launch: occupancy query reports %d\n", per_cu); }
        (void)hipGetLastError();
        grid = cus;
    }
    if (grid < 0) return;
    if (hipMemsetAsync((char*)d_ws + WS_CTL, 0, (MK_SPLIT == 0) ? (size_t)32768 : CTL_ZERO_BYTES, stream) != hipSuccess) return;
    Args a{};
    for (int i = 0; i < 23; ++i) a.in[i] = (const float*)d_in[i];
    a.out = (float*)d_out; a.ws = (unsigned char*)d_ws; a.pad = 0;
#if MK_SPLIT == 0
    a.ph_lo = 0; a.ph_hi = N_PHASES; a.li = 0;
    hipLaunchKernelGGL(trunk_fwd, dim3(grid), dim3(NWAVES * 64), LDS_BYTES, stream, a);
#else
    int li = 0;
    for (int p = 0; p < N_PHASES; p += MK_SPLIT, ++li) {
        a.ph_lo = p; a.ph_hi = (p + MK_SPLIT < N_PHASES) ? p + MK_SPLIT : N_PHASES; a.li = li;
        hipLaunchKernelGGL(trunk_fwd, dim3(grid), dim3(NWAVES * 64), LDS_BYTES, stream, a);
    }
#endif
}
```
